# Optimizing an MI355X kernel written in HIP

```python
import math
import jax, jax.numpy as jnp
from jax import lax
import numpy as np

D_MODEL = 1024
BATCH = 1
SEQ = 16384
DEPTH = 1
DEC_BATCH = 16
DEC_SEQ = 32
PAST_LEN = 4096

CHUNK = 64
Q_BLOCK = 128
D_FF = 2816
D_POOL = D_MODEL // 2
POOL_WINDOWS = (2, 4, 8, 16)
N_POOL_GROUPS = 4
POOL_GROUP = D_POOL // N_POOL_GROUPS
POOL_STATE = max(POOL_WINDOWS) - 1
H_DIFF = 4
HEAD_DIM = D_MODEL // (4 * H_DIFF)
D_ATTN = H_DIFF * 2 * HEAD_DIM
ROT_DIM = HEAD_DIM // 4
ROPE_THETA = 500000.0
N_BRANCH = 2
IN_COLS = D_POOL + 3 * D_ATTN + N_BRANCH * D_MODEL
EPS = 1e-6

kernel_name = "hybrid_pool_diffattn_streaming_step"


def rmsnorm(x, g):
    xf = x.astype(jnp.float32)
    y = xf * lax.rsqrt(jnp.mean(xf * xf, axis=-1, keepdims=True) + EPS)
    return (y * g.astype(jnp.float32)).astype(x.dtype)


def swiglu(x, w_gu, w_down):
    gate, up = jnp.split(x @ w_gu, 2, axis=-1)
    return (jax.nn.silu(gate) * up) @ w_down


def rope_partial(x, pos):
    half = ROT_DIM // 2
    inv = ROPE_THETA ** (-jnp.arange(0, ROT_DIM, 2, dtype=jnp.float32) / ROT_DIM)
    ang = pos.astype(jnp.float32)[:, None] * inv[None, :]
    cos = jnp.cos(ang)[:, None, None, :]
    sin = jnp.sin(ang)[:, None, None, :]
    xr = x[..., :ROT_DIM].astype(jnp.float32)
    x1, x2 = xr[..., :half], xr[..., half:]
    rot = jnp.concatenate([x1 * cos - x2 * sin, x2 * cos + x1 * sin], axis=-1)
    return jnp.concatenate([rot.astype(x.dtype), x[..., ROT_DIM:]], axis=-1)


def pool_mix(ext, n_hist, w_group, scale):
    B, L, C = ext.shape
    T = L - n_hist
    xf = ext.astype(jnp.float32)
    cs = jnp.concatenate([jnp.zeros((B, 1, C), jnp.float32), jnp.cumsum(xf, axis=1)], axis=1)
    hi = jnp.arange(n_hist, L) + 1
    means = []
    for g, w in enumerate(POOL_WINDOWS):
        lo = jnp.maximum(hi - w, 0)
        csg = cs[..., g * POOL_GROUP:(g + 1) * POOL_GROUP]
        cnt = (hi - lo).astype(jnp.float32)[None, :, None]
        means.append((csg[:, hi] - csg[:, lo]) / cnt)
    mixed = jnp.concatenate(means, axis=-1) - xf[:, n_hist:]
    mixed = mixed.reshape(B, T, N_POOL_GROUPS, POOL_GROUP)
    y = jnp.einsum("btgc,gce->btge", mixed, w_group.astype(jnp.float32)).reshape(B, T, C)
    return (y * scale.astype(jnp.float32)).astype(ext.dtype)


def diff_attention(q, k_all, v_all, q_pos, k_pos, lam, q_block):
    B, T = q.shape[0], q.shape[1]
    nb = T // q_block
    qb = jnp.moveaxis(q.reshape(B, nb, q_block, H_DIFF, 2, HEAD_DIM), 1, 0)
    pb = q_pos.reshape(nb, q_block)
    k_chunk = k_pos // CHUNK
    scale = HEAD_DIM ** -0.5

    def one_block(args):
        qi, pi = args
        s = jnp.einsum("bqhcd,bkhcd->bhcqk", qi, k_all).astype(jnp.float32) * scale
        mask = k_chunk[None, :] <= (pi // CHUNK)[:, None]
        p = jax.nn.softmax(jnp.where(mask, s, -jnp.inf), axis=-1)
        a = p[:, :, 0] - lam * p[:, :, 1]
        return jnp.einsum("bhqk,bkhe->bqhe", a.astype(v_all.dtype), v_all)

    out = lax.map(one_block, (qb, pb))
    return jnp.moveaxis(out, 0, 1).reshape(B, T, H_DIFF, 2 * HEAD_DIM)


def encoder_layer(x, k_hist, v_hist, pool_hist, pos0, q_block, lam_init,
                  ffn1_pre_g, ffn1_post_g, ffn1_w_gu, ffn1_w_down,
                  mix_pre_g, mix_post_g, w_in, pool_w, pool_scale,
                  lambda_q1, lambda_k1, lambda_q2, lambda_k2, subln_g,
                  w_branch_pool, w_branch_attn, w_out,
                  ffn2_pre_g, ffn2_post_g, ffn2_w_gu, ffn2_w_down):
    B, T, _ = x.shape
    h = x + 0.5 * rmsnorm(swiglu(rmsnorm(x, ffn1_pre_g), ffn1_w_gu, ffn1_w_down), ffn1_post_g)
    u = rmsnorm(h, mix_pre_g)
    proj = u @ w_in
    u_pool, q, k, v, g = jnp.split(proj, [D_POOL, D_POOL + D_ATTN, D_POOL + 2 * D_ATTN, D_POOL + 3 * D_ATTN], axis=-1)
    q_pos = pos0 + jnp.arange(T)
    q = rope_partial(q.reshape(B, T, H_DIFF, 2, HEAD_DIM), q_pos)
    k = rope_partial(k.reshape(B, T, H_DIFF, 2, HEAD_DIM), q_pos)
    v = v.reshape(B, T, H_DIFF, 2 * HEAD_DIM)
    k_all = jnp.concatenate([k_hist, k], axis=1)
    v_all = jnp.concatenate([v_hist, v], axis=1)
    k_pos = jnp.arange(pos0 + T)
    lam = (jnp.exp(jnp.sum(lambda_q1.astype(jnp.float32) * lambda_k1.astype(jnp.float32)))
           - jnp.exp(jnp.sum(lambda_q2.astype(jnp.float32) * lambda_k2.astype(jnp.float32))) + lam_init)
    attn = diff_attention(q, k_all, v_all, q_pos, k_pos, lam, q_block)
    attn = (rmsnorm(attn, subln_g) * (1.0 - lam_init)).reshape(B, T, D_ATTN)
    ext = jnp.concatenate([pool_hist, u_pool], axis=1)
    pool_out = pool_mix(ext, pool_hist.shape[1], pool_w, pool_scale)
    gates = jax.nn.sigmoid(g.astype(jnp.float32)).reshape(B, T, N_BRANCH, D_MODEL)
    merged = gates[:, :, 0] * (pool_out @ w_branch_pool) + gates[:, :, 1] * (attn @ w_branch_attn)
    h = h + rmsnorm(merged.astype(x.dtype) @ w_out, mix_post_g)
    y = h + 0.5 * rmsnorm(swiglu(rmsnorm(h, ffn2_pre_g), ffn2_w_gu, ffn2_w_down), ffn2_post_g)
    return y, k, v, ext[:, -POOL_STATE:]


def setup_inputs(seed: int = 0) -> dict:
    key = jax.random.key(seed)
    ks = jax.random.split(key, 32)
    f32 = jnp.float32
    nrm = lambda k, shape, s: jax.random.normal(k, shape, f32) * s
    gain = lambda k, n: 1.0 + 0.05 * jax.random.normal(k, (DEPTH, n), f32)
    return {
        "x_prompt": nrm(ks[0], (BATCH, SEQ, D_MODEL), 1.0),
        "x_sample": nrm(ks[1], (DEC_BATCH, DEC_SEQ, D_MODEL), 1.0),
        "cache_k": nrm(ks[2], (DEPTH, DEC_BATCH, PAST_LEN, H_DIFF, 2, HEAD_DIM), 1.0),
        "cache_v": nrm(ks[3], (DEPTH, DEC_BATCH, PAST_LEN, H_DIFF, 2 * HEAD_DIM), 1.0),
        "state_pool": nrm(ks[4], (DEPTH, DEC_BATCH, POOL_STATE, D_POOL), 1.0),
        "ffn1_pre_g": gain(ks[5], D_MODEL),
        "ffn1_post_g": gain(ks[6], D_MODEL),
        "ffn1_w_gu": nrm(ks[7], (DEPTH, D_MODEL, 2 * D_FF), D_MODEL ** -0.5),
        "ffn1_w_down": nrm(ks[8], (DEPTH, D_FF, D_MODEL), D_FF ** -0.5),
        "mix_pre_g": gain(ks[9], D_MODEL),
        "mix_post_g": gain(ks[10], D_MODEL),
        "w_in": nrm(ks[11], (DEPTH, D_MODEL, IN_COLS), D_MODEL ** -0.5),
        "pool_w": nrm(ks[12], (DEPTH, N_POOL_GROUPS, POOL_GROUP, POOL_GROUP), POOL_GROUP ** -0.5),
        "pool_scale": gain(ks[13], D_POOL),
        "lambda_q1": nrm(ks[14], (DEPTH, HEAD_DIM), 0.1),
        "lambda_k1": nrm(ks[15], (DEPTH, HEAD_DIM), 0.1),
        "lambda_q2": nrm(ks[16], (DEPTH, HEAD_DIM), 0.1),
        "lambda_k2": nrm(ks[17], (DEPTH, HEAD_DIM), 0.1),
        "subln_g": gain(ks[18], 2 * HEAD_DIM),
        "w_branch_pool": nrm(ks[19], (DEPTH, D_POOL, D_MODEL), D_POOL ** -0.5),
        "w_branch_attn": nrm(ks[20], (DEPTH, D_ATTN, D_MODEL), D_ATTN ** -0.5),
        "w_out": nrm(ks[21], (DEPTH, D_MODEL, D_MODEL), D_MODEL ** -0.5),
        "ffn2_pre_g": gain(ks[22], D_MODEL),
        "ffn2_post_g": gain(ks[23], D_MODEL),
        "ffn2_w_gu": nrm(ks[24], (DEPTH, D_MODEL, 2 * D_FF), D_MODEL ** -0.5),
        "ffn2_w_down": nrm(ks[25], (DEPTH, D_FF, D_MODEL), D_FF ** -0.5),
    }


def reference(x_prompt, x_sample, cache_k, cache_v, state_pool,
              ffn1_pre_g, ffn1_post_g, ffn1_w_gu, ffn1_w_down,
              mix_pre_g, mix_post_g, w_in, pool_w, pool_scale,
              lambda_q1, lambda_k1, lambda_q2, lambda_k2, subln_g,
              w_branch_pool, w_branch_attn, w_out,
              ffn2_pre_g, ffn2_post_g, ffn2_w_gu, ffn2_w_down):
    yp, ys = x_prompt, x_sample
    kp_l, vp_l, sp_l, ks_l, vs_l, ss_l = [], [], [], [], [], []
    Bp = x_prompt.shape[0]
    for l in range(DEPTH):
        lam_init = 0.8 - 0.6 * math.exp(-0.3 * l)
        w = (ffn1_pre_g[l], ffn1_post_g[l], ffn1_w_gu[l], ffn1_w_down[l],
             mix_pre_g[l], mix_post_g[l], w_in[l], pool_w[l], pool_scale[l],
             lambda_q1[l], lambda_k1[l], lambda_q2[l], lambda_k2[l], subln_g[l],
             w_branch_pool[l], w_branch_attn[l], w_out[l],
             ffn2_pre_g[l], ffn2_post_g[l], ffn2_w_gu[l], ffn2_w_down[l])
        yp, kp, vp, sp = encoder_layer(
            yp,
            jnp.zeros((Bp, 0, H_DIFF, 2, HEAD_DIM), yp.dtype),
            jnp.zeros((Bp, 0, H_DIFF, 2 * HEAD_DIM), yp.dtype),
            jnp.zeros((Bp, 0, D_POOL), yp.dtype),
            0, Q_BLOCK, lam_init, *w)
        ys, k_s, v_s, s_s = encoder_layer(
            ys, cache_k[l], cache_v[l], state_pool[l],
            cache_k.shape[2], ys.shape[1], lam_init, *w)
        kp_l.append(kp); vp_l.append(vp); sp_l.append(sp)
        ks_l.append(k_s); vs_l.append(v_s); ss_l.append(s_s)
    return (yp, ys, jnp.stack(kp_l), jnp.stack(vp_l), jnp.stack(sp_l), jnp.stack(ks_l), jnp.stack(vs_l), jnp.stack(ss_l))
```

```cpp
#include <hip/hip_runtime.h>
#include <hip/hip_cooperative_groups.h>
#include <cstdio>
#include <cstdint>
#include <cmath>
namespace cg = cooperative_groups;
namespace pg8 {
#define PG8_LAS __attribute__((address_space(3)))
typedef unsigned short bf16_t;
typedef short bf16x8 __attribute__((ext_vector_type(8)));
typedef float f32x4 __attribute__((ext_vector_type(4)));
typedef unsigned u32x4 __attribute__((ext_vector_type(4)));
constexpr int BM = 256, BK = 64, HALF = 128, HTB = HALF * BK * 2  , STAGE_BYTES = 8 * HTB, NXCD = 8, WGM = 8;

__host__ __device__ __forceinline__ int lds_byte(int r, int c) { const int st = (r >> 4) * 2 + (c >> 5), rr = r & 15, cc = c & 31, ob = rr * 64 + cc * 2; return st * 1024 + (ob ^ (((ob >> 9) & 1) << 5)); }
__host__ __device__ __forceinline__ void stage_rc(int b, int& R, int& C) { const int st = b / 1024, sb = b % 1024, swz = sb ^ (((sb >> 9) & 1) << 5); R = (st >> 1) * 16 + swz / 64; C = (st & 1) * 32 + (swz % 64) / 2; }
__host__ __device__ __forceinline__ int perm32(int rho) { const int n = rho >> 4, i = rho & 15; return 8 * (i >> 2) + 4 * n + (i & 3); }

struct Unit { int pm, pn, ks; };
struct Gemm { const bf16_t* A; const bf16_t* Bt; int M, N, K; };

struct StaticOrder {
    int nM, nN, nwg, G, c, ntk;
    __host__ __device__ void init(int M, int N, int G_, int c_, int K_) { nM = M / BM; nN = N / BM; nwg = nM * nN; G = G_; c = c_; ntk = K_ / BK; }
    __host__ __device__ bool next(int i, Unit& u) const {
        const long L = (long)i * G + c; if (L >= nwg) return false;
        int wgid = (int)L; { const int q = nwg / NXCD, r = nwg % NXCD, xcd = wgid % NXCD, off = wgid / NXCD; wgid = (xcd < r ? xcd * (q + 1) : r * (q + 1) + (xcd - r) * q) + off; }
        const int nig = WGM * nN, gid = wgid / nig, fm = gid * WGM, gsz = (nM - fm) < WGM ? (nM - fm) : WGM;
        u.pm = fm + ((wgid % nig) % gsz); u.pn = (wgid % nig) / gsz; u.ks = 0; return true;
    }
    __device__ __forceinline__ void a_ready(const Unit&) const {}
    __device__ __forceinline__ void done(const Unit&) const {}
    __device__ __forceinline__ int nt(const Unit&) const { return ntk; }
    __device__ __forceinline__ int kt0(const Unit&) const { return 0; }
};
struct SplitOrder {
    StaticOrder so; int S, ntk, c;
    __host__ __device__ void init(int N, int G_, int c_, int K_, int S_) { so.init(64 * BM, N, G_, c_, K_); S = S_; ntk = K_ / BK; c = c_; }
    __host__ __device__ bool next(int i, Unit& u) const {
        const int L = i * so.G + c;
        if (L >= so.nwg + 8 * S) return false;
        Unit t; t.pm = 0; t.pn = 0; t.ks = 0; (void)so.next(i, t);
        const int j = L - so.nwg, tile = j / S, sp = (int)(L >= so.nwg);
        u.pm = sp ? 64 + (tile >> 2) : t.pm; u.pn = sp ? (tile & 3) : t.pn; u.ks = sp ? j - tile * S : 0; return true;
    }
    __device__ __forceinline__ void a_ready(const Unit&) const {}
    __device__ __forceinline__ void done(const Unit&) const {}
    __device__ __forceinline__ int nt(const Unit& u) const { const int sp = (int)(u.pm >= 64), nts = ntk / S; return ntk - sp * (ntk - nts); }
    __device__ __forceinline__ int kt0(const Unit& u) const { const int sp = (int)(u.pm >= 64); return sp * u.ks * (ntk / S); }
};

__device__ __forceinline__ unsigned cvt_pk_bf16(float lo, float hi) { unsigned r; asm volatile("v_cvt_pk_bf16_f32 %0, %1, %2" : "=v"(r) : "v"(lo), "v"(hi)); return r; }
typedef float f32x2 __attribute__((ext_vector_type(2)));
__device__ __forceinline__ float sigm(float x) { return __builtin_amdgcn_rcpf(1.f + __builtin_amdgcn_exp2f(-1.4426950408889634f * x)); }
__device__ __forceinline__ float bf_lo(unsigned w) { return __uint_as_float(w << 16); }
__device__ __forceinline__ float bf_hi(unsigned w) { return __uint_as_float(w & 0xffff0000u); }
__device__ __forceinline__ u32x4 pack8(const f32x4 a, const f32x4 b) { u32x4 w; w.x = cvt_pk_bf16(a[0], a[1]); w.y = cvt_pk_bf16(a[2], a[3]); w.z = cvt_pk_bf16(b[0], b[1]); w.w = cvt_pk_bf16(b[2], b[3]); return w; }

struct EpiSwiglu {
    static constexpr bool PERM = true, AFTER_DRAIN = false;
    bf16_t* O; int ldc;
    __device__ __forceinline__ void operator()(const f32x4 (&acc)[2][2][4][2], const Unit& u, int wr, int wc, int fr, int fq) const {
        const int row0 = u.pm * BM + wr * 64 + fr, col0 = u.pn * HALF + wc * 32 + 8 * fq;
#pragma unroll
        for (int ai = 0; ai < 2; ++ai)
#pragma unroll
            for (int m = 0; m < 4; ++m) {
                f32x4 h0, h1;
#pragma unroll
                for (int i = 0; i < 4; ++i) { const float g0 = acc[ai][0][m][0][i], g1 = acc[ai][0][m][1][i]; h0[i] = g0 * sigm(g0) * acc[ai][1][m][0][i]; h1[i] = g1 * sigm(g1) * acc[ai][1][m][1][i]; }
                *(u32x4*)(O + (size_t)(row0 + ai * HALF + m * 16) * ldc + col0) = pack8(h0, h1);
            }
    }
};
struct EpiF32 {
    static constexpr bool PERM = false, AFTER_DRAIN = false;
    float* O; int ldc; float* DP;
    __device__ __forceinline__ void operator()(const f32x4 (&acc)[2][2][4][2], const Unit& u, int wr, int wc, int fr, int fq) const {
        const int row0 = u.pm * BM + wr * 64 + fr, col0 = u.pn * BM + wc * 32 + 4 * fq;
        float* base = (DP && u.pm >= 64) ? DP + ((size_t)u.ks * 512 - 16384) * 1024 : O;
#pragma unroll
        for (int ai = 0; ai < 2; ++ai)
#pragma unroll
            for (int m = 0; m < 4; ++m) { float* rp = base + (size_t)(row0 + ai * HALF + m * 16) * ldc + col0;
#pragma unroll
                for (int bj = 0; bj < 2; ++bj)
#pragma unroll
                    for (int n = 0; n < 2; ++n) *(f32x4*)(rp + bj * HALF + n * 16) = acc[ai][bj][m][n]; }
    }
};
struct EpiMergeA {
    static constexpr bool PERM = true, AFTER_DRAIN = false;
    const bf16_t* G; float* MG;
    __device__ __forceinline__ void operator()(const f32x4 (&acc)[2][2][4][2], const Unit& u, int wr, int wc, int fr, int fq) const {
        const int row0 = u.pm * BM + wr * 64 + fr, col0 = u.pn * BM + wc * 32 + 8 * fq;
#pragma unroll
        for (int ai = 0; ai < 2; ++ai)
#pragma unroll
            for (int m = 0; m < 4; ++m) { const size_t row = (size_t)(row0 + ai * HALF + m * 16);
#pragma unroll
                for (int bj = 0; bj < 2; ++bj) { const int c0 = col0 + bj * HALF; const u32x4 g = *(const u32x4*)(G + row * 2048 + c0);
                    const f32x4 a = acc[ai][bj][m][0], b = acc[ai][bj][m][1];
                    f32x4 o0 = {a[0] * bf_lo(g.x), a[1] * bf_hi(g.x), a[2] * bf_lo(g.y), a[3] * bf_hi(g.y)}, o1 = {b[0] * bf_lo(g.z), b[1] * bf_hi(g.z), b[2] * bf_lo(g.w), b[3] * bf_hi(g.w)};
                    *(f32x4*)(MG + row * 1024 + c0) = o0; *(f32x4*)(MG + row * 1024 + c0 + 4) = o1; } }
    }
};
struct EpiMergeB {
    static constexpr bool PERM = true, AFTER_DRAIN = false;
    const bf16_t* G; const float* MG; bf16_t* O;
    __device__ __forceinline__ void operator()(const f32x4 (&acc)[2][2][4][2], const Unit& u, int wr, int wc, int fr, int fq) const {
        const int row0 = u.pm * BM + wr * 64 + fr, col0 = u.pn * BM + wc * 32 + 8 * fq;
#pragma unroll
        for (int ai = 0; ai < 2; ++ai)
#pragma unroll
            for (int m = 0; m < 4; ++m) { const size_t row = (size_t)(row0 + ai * HALF + m * 16);
#pragma unroll
                for (int bj = 0; bj < 2; ++bj) { const int c0 = col0 + bj * HALF; const u32x4 g = *(const u32x4*)(G + row * 2048 + 1024 + c0);
                    const f32x4 m0 = *(const f32x4*)(MG + row * 1024 + c0), m1 = *(const f32x4*)(MG + row * 1024 + c0 + 4);
                    const f32x4 a = acc[ai][bj][m][0], b = acc[ai][bj][m][1];
                    f32x4 o0 = {m0[0] + a[0] * bf_lo(g.x), m0[1] + a[1] * bf_hi(g.x), m0[2] + a[2] * bf_lo(g.y), m0[3] + a[3] * bf_hi(g.y)};
                    f32x4 o1 = {m1[0] + b[0] * bf_lo(g.z), m1[1] + b[1] * bf_hi(g.z), m1[2] + b[2] * bf_lo(g.w), m1[3] + b[3] * bf_hi(g.w)};
                    *(u32x4*)(O + row * 1024 + c0) = pack8(o0, o1); } }
    }
};
constexpr int EW_MP = 16384;
constexpr size_t EW_OFF_KP = 17301504, EW_OFF_VP = 25690112, EW_OFF_PP = 34078720, EW_OFF_KS = 34086400, EW_OFF_VS = 34348544, EW_OFF_PS = 34610688;
struct EpiWin {
    static constexpr bool PERM = true, AFTER_DRAIN = false;
    bf16_t *UPOOL, *Q, *K, *VT, *GATES; float* out; double rc[8];
    __device__ __forceinline__ void operator()(const f32x4 (&acc)[2][2][4][2], const Unit& u, int wr, int wc, int fr, int fq) const {
        const int pn = u.pn, row0 = u.pm * BM + wr * 64 + fr, cl = wc * 32 + 8 * fq;
        if (pn < 2) {
#pragma unroll
            for (int ai = 0; ai < 2; ++ai)
#pragma unroll
                for (int m = 0; m < 4; ++m) { const int row = row0 + ai * HALF + m * 16;
                    long po = -1;
                    if (row >= EW_MP - 15 && row < EW_MP) po = (long)EW_OFF_PP + (long)(row - (EW_MP - 15)) * 512;
                    else if (row >= EW_MP) { const int t = (row - EW_MP) & 31, b = (row - EW_MP) >> 5; if (t >= 17) po = (long)EW_OFF_PS + (long)(b * 15 + t - 17) * 512; }
#pragma unroll
                    for (int bj = 0; bj < 2; ++bj) { const int c0 = pn * BM + bj * HALF + cl;
                        *(u32x4*)(UPOOL + (size_t)row * 512 + c0) = pack8(acc[ai][bj][m][0], acc[ai][bj][m][1]);
                        if (po >= 0) { *(f32x4*)(out + po + c0) = acc[ai][bj][m][0]; *(f32x4*)(out + po + c0 + 4) = acc[ai][bj][m][1]; } } }
        } else if (pn < 6) {
            const bool is_k = pn >= 4; const bool ropew = (wc & 1) == 0;
#pragma unroll
            for (int ai = 0; ai < 2; ++ai)
#pragma unroll
                for (int m = 0; m < 4; ++m) { const int row = row0 + ai * HALF + m * 16;
                    f32x4 v[2][2] = {{acc[ai][0][m][0], acc[ai][0][m][1]}, {acc[ai][1][m][0], acc[ai][1][m][1]}};
                    if (ropew) {
                        const double pos = (double)(row < EW_MP ? row : 4096 + ((row - EW_MP) & 31));
#pragma unroll
                        for (int n = 0; n < 2; ++n)
#pragma unroll
                            for (int i = 0; i < 4; ++i) { const double rev = pos * rc[n * 4 + i]; const float f = (float)(rev - __builtin_rint(rev));
                                const float sn = __builtin_amdgcn_sinf(f), cs = __builtin_amdgcn_cosf(f);
#pragma unroll
                                for (int bj = 0; bj < 2; ++bj) { const float x = v[bj][n][i], p = __shfl_xor(x, 16);
                                    const float r = (fq == 0) ? x * cs - p * sn : x * cs + p * sn; v[bj][n][i] = (fq < 2) ? r : x; } }
                    }
#pragma unroll
                    for (int bj = 0; bj < 2; ++bj) { const int cq = (pn & 1) * BM + bj * HALF + cl;
                        const float qs = is_k ? 1.0f : 0.18033688011112042f;
                        *(u32x4*)((is_k ? K : Q) + (size_t)row * 512 + cq) = pack8(v[bj][0] * qs, v[bj][1] * qs);
                        if (is_k) { float* o = out + (row < EW_MP ? EW_OFF_KP + (size_t)row * 512 : EW_OFF_KS + (size_t)(row - EW_MP) * 512) + cq; *(f32x4*)o = v[bj][0]; *(f32x4*)(o + 4) = v[bj][1]; } } }
        } else if (pn < 8) {
#pragma unroll
            for (int ai = 0; ai < 2; ++ai)
#pragma unroll
                for (int m = 0; m < 4; ++m) { const int row = row0 + ai * HALF + m * 16;
                    const int k16 = row & 15, tp = (row & ~15) | ((k16 & 3) + ((k16 >> 3) & 1) * 4 + ((k16 >> 2) & 1) * 8);
#pragma unroll
                    for (int bj = 0; bj < 2; ++bj) { const int cv = (pn & 1) * BM + bj * HALF + cl;
                        float* o = out + (row < EW_MP ? EW_OFF_VP + (size_t)row * 512 : EW_OFF_VS + (size_t)(row - EW_MP) * 512) + cv; *(f32x4*)o = acc[ai][bj][m][0]; *(f32x4*)(o + 4) = acc[ai][bj][m][1];
                        if (row < EW_MP) { const u32x4 w = pack8(acc[ai][bj][m][0], acc[ai][bj][m][1]); bf16_t* vp = VT + (size_t)cv * EW_MP + tp;
                            vp[0] = (bf16_t)w.x; vp[EW_MP] = (bf16_t)(w.x >> 16); vp[2 * EW_MP] = (bf16_t)w.y; vp[3 * EW_MP] = (bf16_t)(w.y >> 16);
                            vp[4 * EW_MP] = (bf16_t)w.z; vp[5 * EW_MP] = (bf16_t)(w.z >> 16); vp[6 * EW_MP] = (bf16_t)w.w; vp[7 * EW_MP] = (bf16_t)(w.w >> 16); } } }
        } else {
#pragma unroll
            for (int ai = 0; ai < 2; ++ai)
#pragma unroll
                for (int m = 0; m < 4; ++m) { const int row = row0 + ai * HALF + m * 16;
#pragma unroll
                    for (int bj = 0; bj < 2; ++bj) { const int c0 = (pn - 8) * BM + bj * HALF + cl; f32x4 a = acc[ai][bj][m][0], b = acc[ai][bj][m][1];
#pragma unroll
                        for (int i = 0; i < 4; ++i) { a[i] = sigm(a[i]); b[i] = sigm(b[i]); }
                        *(u32x4*)(GATES + (size_t)row * 2048 + c0) = pack8(a, b); } }
        }
    }
};
template <class Epi, class Sched, bool ALIGN_EPI = false, bool SP2 = false>
__device__ __forceinline__ void gemm_phase(PG8_LAS unsigned char* lds, const Gemm g, const Sched& S, const Epi& E) {
    const int tid = threadIdx.x, wid = __builtin_amdgcn_readfirstlane(tid >> 6), lane = tid & 63, wr = wid >> 2, wc = wid & 3, fr = lane & 15, fq = lane >> 4;
    const int K = g.K; int nt;
    unsigned voffA[2], voffB[2];
#pragma unroll
    for (int i = 0; i < 2; ++i) { int R, C; stage_rc(tid * 16 + i * 8192, R, C); const int Rb = Epi::PERM ? ((R & ~31) + perm32(R & 31)) : R;
        voffA[i] = (unsigned)(R * K + C) * 2u; voffB[i] = (unsigned)(Rb * K + C) * 2u; }
    const size_t kstep = (size_t)(BK * 2);
    const size_t hstep = (size_t)HALF * K * 2;
    const size_t tstep = 2 * hstep;
    const unsigned ldsw = (unsigned)wid * 1024u;
    const int aoff = lds_byte(wr * 64 + fr, fq * 8), boff = lds_byte(wc * 32 + fr, fq * 8);
#define PG8_SA(b, h) (((b) * 2 + (h)) * HTB)
#define PG8_SB(b, h) ((4 + (b) * 2 + (h)) * HTB)
#define PG8_STAGE(bufoff, gbase, voff) do { _Pragma("unroll") for (int _i = 0; _i < 2; ++_i) \
        __builtin_amdgcn_global_load_lds((const unsigned*)((const char*)(gbase) + (voff)[_i]), (PG8_LAS unsigned*)(lds + (bufoff) + ldsw + _i * 8192), 16, 0, 0); } while (0)
#define PG8_LDA(dst, b, h) do { _Pragma("unroll") for (int m = 0; m < 4; ++m) _Pragma("unroll") for (int k = 0; k < 2; ++k) dst[m][k] = *(const PG8_LAS bf16x8*)(lds + PG8_SA(b, h) + aoff + m * 2048 + k * 1024); } while (0)
#define PG8_LDB(dst, b, h) do { _Pragma("unroll") for (int n = 0; n < 2; ++n) _Pragma("unroll") for (int k = 0; k < 2; ++k) dst[n][k] = *(const PG8_LAS bf16x8*)(lds + PG8_SB(b, h) + boff + n * 2048 + k * 1024); } while (0)
#define PG8_MMA(ai, bj, At, Bt) do { __builtin_amdgcn_s_setprio(1); _Pragma("unroll") for (int m = 0; m < 4; ++m) _Pragma("unroll") for (int n = 0; n < 2; ++n) _Pragma("unroll") for (int k = 0; k < 2; ++k) \
        acc[ai][bj][m][n] = __builtin_amdgcn_mfma_f32_16x16x32_bf16(Bt[n][k], At[m][k], acc[ai][bj][m][n], 0, 0, 0); __builtin_amdgcn_s_setprio(0); } while (0)
#define PG8_WAIT_V(n) asm volatile("s_waitcnt vmcnt(" #n ")" ::: "memory")
#define PG8_WAIT_L(n) asm volatile("s_waitcnt lgkmcnt(" #n ")" ::: "memory")
#define PG8_BAR __builtin_amdgcn_s_barrier()
#define PG8_SCHED __builtin_amdgcn_sched_barrier(0)
    Unit cur, nxt; int ui = 0;
    if (!S.next(0, cur)) return;
    f32x4 acc[2][2][4][2];
#pragma unroll
    for (int a = 0; a < 2; ++a)
#pragma unroll
        for (int b = 0; b < 2; ++b)
#pragma unroll
            for (int m = 0; m < 4; ++m)
#pragma unroll
                for (int n = 0; n < 2; ++n) acc[a][b][m][n] = (f32x4){0.f, 0.f, 0.f, 0.f};
    bf16x8 At[4][2], B0[2][2], B1[2][2];
    const char* cA = (const char*)g.A + (size_t)cur.pm * tstep + (size_t)S.kt0(cur) * kstep; const char* cB = (const char*)g.Bt + (size_t)cur.pn * tstep + (size_t)S.kt0(cur) * kstep; nt = S.nt(cur);
    S.a_ready(cur);
    if constexpr (SP2) {
        PG8_STAGE(PG8_SB(0, 0), cB, voffB); PG8_STAGE(PG8_SB(0, 1), cB + hstep, voffB); PG8_STAGE(PG8_SA(0, 0), cA, voffA); PG8_STAGE(PG8_SA(0, 1), cA + hstep, voffA);
        if (wr == 1) PG8_BAR;
        PG8_WAIT_V(2); PG8_BAR;
        PG8_STAGE(PG8_SB(1, 0), cB + kstep, voffB); PG8_STAGE(PG8_SA(1, 0), cA + kstep, voffA); PG8_STAGE(PG8_SB(1, 1), cB + hstep + kstep, voffB);
        PG8_WAIT_V(6); PG8_BAR;
    } else {
        PG8_STAGE(PG8_SB(0, 0), cB, voffB); PG8_STAGE(PG8_SA(0, 0), cA, voffA); PG8_STAGE(PG8_SB(0, 1), cB + hstep, voffB); PG8_STAGE(PG8_SA(0, 1), cA + hstep, voffA);
        if (wr == 1) PG8_BAR;
        PG8_WAIT_V(4); PG8_BAR;
        PG8_STAGE(PG8_SB(1, 0), cB + kstep, voffB); PG8_STAGE(PG8_SA(1, 0), cA + kstep, voffA); PG8_STAGE(PG8_SB(1, 1), cB + hstep + kstep, voffB);
        PG8_WAIT_V(6); PG8_BAR;
    }
    for (;;) {
        const bool has_next = S.next(ui + 1, nxt);
        const char* nA = has_next ? (const char*)g.A + (size_t)nxt.pm * tstep + (size_t)S.kt0(nxt) * kstep : cA; const char* nB = has_next ? (const char*)g.Bt + (size_t)nxt.pn * tstep + (size_t)S.kt0(nxt) * kstep : cB;
        for (int t = 0; t < nt; t += 2) {
            const bool last = (t == nt - 2);
            const char* a1 = cA + (size_t)(t + 1) * kstep;
            const char* a2 = last ? nA : cA + (size_t)(t + 2) * kstep; const char* b2 = last ? nB : cB + (size_t)(t + 2) * kstep;
            const char* a3 = a2 + kstep; const char* b3 = b2 + kstep;
            if (last && has_next) S.a_ready(nxt);
            if constexpr (SP2) {
            PG8_LDB(B0, 0, 0); PG8_LDB(B1, 0, 1); PG8_SCHED; PG8_LDA(At, 0, 0); PG8_STAGE(PG8_SA(1, 1), a1 + hstep, voffA);
            PG8_WAIT_V(8); PG8_WAIT_L(0); PG8_BAR; PG8_MMA(0, 0, At, B0); PG8_MMA(0, 1, At, B1); PG8_BAR; PG8_SCHED;
            PG8_LDA(At, 0, 1); PG8_STAGE(PG8_SB(0, 0), b2, voffB); PG8_STAGE(PG8_SB(0, 1), b2 + hstep, voffB); PG8_STAGE(PG8_SA(0, 0), a2, voffA);
            PG8_WAIT_V(8); PG8_WAIT_L(0); PG8_BAR; PG8_MMA(1, 0, At, B0); PG8_MMA(1, 1, At, B1); PG8_BAR; PG8_SCHED;
            PG8_LDB(B0, 1, 0); PG8_LDB(B1, 1, 1); PG8_SCHED; PG8_LDA(At, 1, 0); PG8_STAGE(PG8_SA(0, 1), a2 + hstep, voffA);
            PG8_WAIT_V(8); PG8_WAIT_L(0); PG8_BAR; PG8_MMA(0, 0, At, B0); PG8_MMA(0, 1, At, B1); PG8_BAR; PG8_SCHED;
            PG8_LDA(At, 1, 1); PG8_STAGE(PG8_SB(1, 0), b3, voffB); PG8_STAGE(PG8_SB(1, 1), b3 + hstep, voffB); PG8_STAGE(PG8_SA(1, 0), a3, voffA);
            PG8_WAIT_V(8); PG8_WAIT_L(0); PG8_BAR; PG8_MMA(1, 0, At, B0); PG8_MMA(1, 1, At, B1); PG8_BAR; PG8_SCHED;
            } else {
            PG8_LDB(B0, 0, 0); PG8_SCHED; PG8_LDA(At, 0, 0); PG8_STAGE(PG8_SA(1, 1), a1 + hstep, voffA);
            PG8_WAIT_L(8); PG8_BAR; PG8_WAIT_L(0); PG8_MMA(0, 0, At, B0); PG8_BAR; PG8_SCHED;
            PG8_LDB(B1, 0, 1); PG8_STAGE(PG8_SB(0, 0), b2, voffB);
            PG8_BAR; PG8_WAIT_L(0); PG8_MMA(0, 1, At, B1); PG8_BAR;
            PG8_LDA(At, 0, 1); PG8_STAGE(PG8_SA(0, 0), a2, voffA);
            PG8_BAR; PG8_WAIT_L(0); PG8_MMA(1, 0, At, B0); PG8_BAR; PG8_SCHED;
            PG8_STAGE(PG8_SB(0, 1), b2 + hstep, voffB);
            PG8_WAIT_V(6); PG8_BAR; PG8_MMA(1, 1, At, B1); PG8_BAR;
            PG8_LDB(B0, 1, 0); PG8_SCHED; PG8_LDA(At, 1, 0); PG8_STAGE(PG8_SA(0, 1), a2 + hstep, voffA);
            PG8_WAIT_L(8); PG8_BAR; PG8_WAIT_L(0); PG8_MMA(0, 0, At, B0); PG8_BAR; PG8_SCHED;
            PG8_LDB(B1, 1, 1); PG8_STAGE(PG8_SB(1, 0), b3, voffB);
            PG8_BAR; PG8_WAIT_L(0); PG8_MMA(0, 1, At, B1); PG8_BAR;
            PG8_LDA(At, 1, 1); PG8_STAGE(PG8_SA(1, 0), a3, voffA);
            PG8_BAR; PG8_WAIT_L(0); PG8_MMA(1, 0, At, B0); PG8_BAR; PG8_SCHED;
            PG8_STAGE(PG8_SB(1, 1), b3 + hstep, voffB);
            PG8_WAIT_V(6); PG8_BAR; PG8_MMA(1, 1, At, B1); PG8_BAR;
            }
        }
        if constexpr (ALIGN_EPI) { if (wr == 0) PG8_BAR; }
        if constexpr (!Epi::AFTER_DRAIN) { E(acc, cur, wr, wc, fr, fq); S.done(cur); }
        if (!has_next) break;
#pragma unroll
        for (int a = 0; a < 2; ++a)
#pragma unroll
            for (int b = 0; b < 2; ++b)
#pragma unroll
                for (int m = 0; m < 4; ++m)
#pragma unroll
                    for (int n = 0; n < 2; ++n) acc[a][b][m][n] = (f32x4){0.f, 0.f, 0.f, 0.f};
        cur = nxt; cA = nA; cB = nB; nt = S.nt(cur); ++ui;
        if constexpr (ALIGN_EPI) { if (wr == 1) PG8_BAR; }
    }
    PG8_WAIT_V(0);
    if constexpr (!ALIGN_EPI) { if (wr == 0) PG8_BAR; }
    PG8_BAR;
    if constexpr (Epi::AFTER_DRAIN) { E.fused(acc, cur, wr, wc, fr, fq, lds, wid, lane); S.done(cur); }
#undef PG8_SA
#undef PG8_SB
#undef PG8_STAGE
#undef PG8_LDA
#undef PG8_LDB
#undef PG8_MMA
#undef PG8_WAIT_V
#undef PG8_WAIT_L
#undef PG8_BAR
#undef PG8_SCHED
}
}
#define LAS __attribute__((address_space(3)))
typedef unsigned short bf16;
typedef short bf16x8 __attribute__((ext_vector_type(8)));
typedef float f32x4 __attribute__((ext_vector_type(4)));
typedef float f32x16 __attribute__((ext_vector_type(16)));
typedef unsigned u32x4 __attribute__((ext_vector_type(4)));
typedef unsigned u32x2 __attribute__((ext_vector_type(2)));

constexpr int DMODEL = 1024, MP = 16384, MS = 512, M = MP + MS, DFF = 2816, NGU = 2 * DFF, PASTL = 4096;
constexpr float EPS = 1e-6f, LAM_INIT = 0.2f;
constexpr size_t OFF_KP = 17301504, OFF_VP = 25690112, OFF_PP = 34078720, OFF_KS = 34086400, OFF_VS = 34348544, OFF_PS = 34610688, OUT_TOTAL = 34733568;
constexpr size_t MiB = 1u << 20;
constexpr size_t WS_WGU1 = 2 * MiB, WS_WD1 = 13 * MiB, WS_WIN = 19 * MiB, WS_WC = 27 * MiB, WS_WBA = 28 * MiB, WS_WOUT = 29 * MiB, WS_WGU2 = 31 * MiB, WS_WD2 = 42 * MiB;
constexpr size_t WS_XN = 48 * MiB, WS_HID = 81 * MiB, WS_D = 172 * MiB, WS_H = 238 * MiB, WS_UPOOL = 304 * MiB, WS_Q = 321 * MiB, WS_K = 338 * MiB, WS_VT = 355 * MiB;
constexpr size_t WS_GATES = 371 * MiB, WS_MIXED = 437 * MiB, WS_ATTN = 454 * MiB, WS_SPART = 471 * MiB, WS_DP = 480 * MiB, WS_END = 502 * MiB;
constexpr int SPART_FLOATS = 64 * 64 + 128;
constexpr int LDS_BYTES = 155712;
constexpr int NPH = 14;
#ifndef POOL_REP
#define POOL_REP 1
#endif
#ifndef SAMP_REP
#define SAMP_REP 1
#endif
#ifndef SYNC_REP
#define SYNC_REP 0
#endif
#ifndef ATT_REP
#define ATT_REP 1
#endif
#ifndef REP_MASK
#define REP_MASK 0
#endif

__device__ __forceinline__ float wave_sum(float v) {
#pragma unroll
    for (int o = 1; o < 64; o <<= 1) v += __shfl_xor(v, o);
    return v;
}
__device__ __forceinline__ unsigned pk2(float lo, float hi) { return pg8::cvt_pk_bf16(lo, hi); }
__device__ __forceinline__ bf16x8 pack_bf8(float a0, float a1, float a2, float a3, float a4, float a5, float a6, float a7) {
    u32x4 w; w.x = pk2(a0, a1); w.y = pk2(a2, a3); w.z = pk2(a4, a5); w.w = pk2(a6, a7); return __builtin_bit_cast(bf16x8, w);
}
typedef float f32x2_t __attribute__((ext_vector_type(2))); typedef __bf16 bf16x2_t __attribute__((ext_vector_type(2)));
__device__ __forceinline__ unsigned pk2v(float lo, float hi) { f32x2_t v = {lo, hi}; bf16x2_t b = __builtin_convertvector(v, bf16x2_t); return __builtin_bit_cast(unsigned, b); }
__device__ __forceinline__ bf16x8 pack_bf8v(float a0, float a1, float a2, float a3, float a4, float a5, float a6, float a7) {
    u32x4 w; w.x = pk2v(a0, a1); w.y = pk2v(a2, a3); w.z = pk2v(a4, a5); w.w = pk2v(a6, a7); return __builtin_bit_cast(bf16x8, w);
}
__device__ __forceinline__ f32x16 mfma32(bf16x8 a, bf16x8 b, f32x16 c) { return __builtin_amdgcn_mfma_f32_32x32x16_bf16(a, b, c, 0, 0, 0); }

__device__ __forceinline__ void transpose_item(const float* W, int ldw, int K, bf16* WT, int dst_row0, int src_n0, int k0, LAS float* scr, int lane) {
#pragma unroll 8
    for (int i = 0; i < 32; ++i) { const int kk = 2 * i + (lane >> 5); scr[kk * 33 + (lane & 31)] = W[(size_t)(k0 + kk) * ldw + src_n0 + (lane & 31)]; }
    asm volatile("s_waitcnt lgkmcnt(0)" ::: "memory");
    const int c = lane & 7;
#pragma unroll
    for (int j = 0; j < 4; ++j) { const int n = (lane >> 3) + 8 * j; const LAS float* s = scr + (8 * c) * 33 + n;
        u32x4 o; o.x = pk2(s[0 * 33], s[1 * 33]); o.y = pk2(s[2 * 33], s[3 * 33]); o.z = pk2(s[4 * 33], s[5 * 33]); o.w = pk2(s[6 * 33], s[7 * 33]);
        *(u32x4*)(WT + (size_t)(dst_row0 + n) * K + k0 + 8 * c) = o; }
    asm volatile("s_waitcnt lgkmcnt(0)" ::: "memory");
}
__device__ __forceinline__ void transpose_mat(const float* W, int K, int N, bf16* WT, bool gu, int gw, int NGW, LAS float* scr, int lane) {
    const int nblk = N / 32, nitems = (K / 64) * nblk;
    for (int it = gw; it < nitems; it += NGW) { const int kb = it / nblk, nb = it % nblk; int src = 32 * nb;
        if (gu) { const int tile = (32 * nb) / 256, within = (32 * nb) % 256; src = within < 128 ? tile * 128 + within : DFF + tile * 128 + within - 128; }
        transpose_item(W, N, K, WT, 32 * nb, src, 64 * kb, scr, lane); }
}
__device__ __forceinline__ const float* xrow_ptr(const float* xp, const float* xs, int row) { return row < MP ? xp + (size_t)row * DMODEL : xs + (size_t)(row - MP) * DMODEL; }
__device__ __forceinline__ void norm_row_bf16(const f32x4 (&v)[4], const float* g, bf16* orow, int lane) {
    float s = 0.f;
#pragma unroll
    for (int j = 0; j < 4; ++j) s += (v[j][0] * v[j][0] + v[j][1] * v[j][1]) + (v[j][2] * v[j][2] + v[j][3] * v[j][3]);
    const float r = 1.0f / sqrtf(wave_sum(s) * (1.f / DMODEL) + EPS);
#pragma unroll
    for (int j = 0; j < 4; ++j) { const f32x4 gg = *((const f32x4*)g + lane + 64 * j); u32x2 w; w.x = pk2(v[j][0] * r * gg[0], v[j][1] * r * gg[1]); w.y = pk2(v[j][2] * r * gg[2], v[j][3] * r * gg[3]);
        *((u32x2*)orow + lane + 64 * j) = w; }
}
__device__ __forceinline__ void resnorm_rows(const float* xp, const float* xs, const float* Hbase, const float* D, const float* DP, int nslab, float rs, const float* gpost, float* outf, const float* gnext, bf16* XN, int gw, int NGW, int lane) {
    for (int row = gw; row < M; row += NGW) {
        const float* b = Hbase ? Hbase + (size_t)row * DMODEL : xrow_ptr(xp, xs, row);
        f32x4 d[4], h[4]; float s = 0.f;
#pragma unroll
        for (int j = 0; j < 4; ++j) { h[j] = *((const f32x4*)b + lane + 64 * j);
            if (row < MP) d[j] = *((const f32x4*)(D + (size_t)row * DMODEL) + lane + 64 * j);
            else { d[j] = *((const f32x4*)(DP + (size_t)(row - MP) * DMODEL) + lane + 64 * j); for (int sl = 1; sl < nslab; ++sl) d[j] += *((const f32x4*)(DP + ((size_t)sl * 512 + row - MP) * DMODEL) + lane + 64 * j); }
            s += (d[j][0] * d[j][0] + d[j][1] * d[j][1]) + (d[j][2] * d[j][2] + d[j][3] * d[j][3]); }
        const float r = rs / sqrtf(wave_sum(s) * (1.f / DMODEL) + EPS);
#pragma unroll
        for (int j = 0; j < 4; ++j) { const f32x4 gg = *((const f32x4*)gpost + lane + 64 * j); h[j] = h[j] + d[j] * gg * r; *((f32x4*)(outf + (size_t)row * DMODEL) + lane + 64 * j) = h[j]; }
        if (gnext) norm_row_bf16(h, gnext, XN + (size_t)row * DMODEL, lane);
    }
}
__device__ __forceinline__ float compute_lam(const float* q1, const float* k1, const float* q2, const float* k2, int lane) {
    const float a = wave_sum(q1[lane] * k1[lane]), b = wave_sum(q2[lane] * k2[lane]);
    const float l = expf(a) - expf(b) + LAM_INIT;
    return __builtin_bit_cast(float, __builtin_amdgcn_readfirstlane(__builtin_bit_cast(int, l)));
}

namespace att {
constexpr int KSTR = 272, VSTR = 144, KBUF = 64 * KSTR, VBUF = 128 * VSTR, STAGE = KBUF + VBUF;
constexpr float C2 = 0.125f * 1.4426950408889634f, THR = 8.0f;
__device__ __forceinline__ int crow(int r, int hi) { return (r & 3) + 8 * (r >> 2) + 4 * hi; }
__device__ __forceinline__ float max3f(float a, float b, float c) { return __builtin_fmaxf(__builtin_fmaxf(a, b), c); }
__device__ __forceinline__ float max16(const f32x16& p) { float m = max3f(p[0], p[1], p[2]); m = max3f(m, p[3], p[4]); m = max3f(m, p[5], p[6]); m = max3f(m, p[7], p[8]);
    m = max3f(m, p[9], p[10]); m = max3f(m, p[11], p[12]); m = max3f(m, p[13], p[14]); return __builtin_fmaxf(m, p[15]); }

__device__ __forceinline__ void finish_store(f32x16 (&o)[4], const float* sg, bf16* orow, int hi) {
    float ss = 0.f;
#pragma unroll
    for (int cb = 0; cb < 4; ++cb)
#pragma unroll
        for (int r = 0; r < 16; ++r) ss += o[cb][r] * o[cb][r];
    ss += __shfl_xor(ss, 32);
    const float rn = (1.0f - LAM_INIT) / sqrtf(ss * (1.f / 128.f) + EPS);
#pragma unroll
    for (int cb = 0; cb < 4; ++cb)
#pragma unroll
        for (int r4 = 0; r4 < 4; ++r4) { const int col = cb * 32 + 8 * r4 + 4 * hi; const f32x4 g = *(const f32x4*)(sg + col);
            u32x2 w; w.x = pk2(o[cb][4 * r4] * rn * g[0], o[cb][4 * r4 + 1] * rn * g[1]); w.y = pk2(o[cb][4 * r4 + 2] * rn * g[2], o[cb][4 * r4 + 3] * rn * g[3]);
            *(u32x2*)(orow + col) = w; }
}

constexpr int DSTG = 32768;
__device__ __forceinline__ void prompt_unit(int h, int qb, const bf16* Q, const bf16* K, const bf16* VT, bf16* ATTN, float lam, const float* sg, LAS char* lds) {
    int tid = threadIdx.x; asm volatile("" : "+v"(tid));
    const int lane = tid & 63, r32 = lane & 31, hi = lane >> 5, wid = __builtin_amdgcn_readfirstlane(tid >> 6), rg = wid & 3, c = wid >> 2;
    const int qrow = 128 * qb + 32 * rg + r32;
    bf16x8 qf0;
    LAS char* qlds = lds + 4 * DSTG + wid * 3072 + lane * 16;
    qf0 = *(const bf16x8*)(Q + (size_t)qrow * 512 + h * 128 + c * 64 + 8 * hi);
#pragma unroll
    for (int d0 = 1; d0 < 4; ++d0) *(LAS bf16x8*)(qlds + (d0 - 1) * 1024) = *(const bf16x8*)(Q + (size_t)qrow * 512 + h * 128 + c * 64 + 16 * d0 + 8 * hi);
#define QFR(d0) ((d0) == 0 ? qf0 : *(const LAS bf16x8*)(qlds + ((d0) - 1) * 1024))
    const int ntiles = 2 * qb + 2, myn = 2 * qb + 1 + (rg >> 1);
    unsigned ksrc0, vsrc0;
    { const int row = 4 * rg + (lane >> 4), ch = (lane & 15) ^ (row & 15); ksrc0 = (unsigned)(row * 512 + h * 128) * 2u + (unsigned)ch * 16u; }
    { const int row = 8 * rg + (lane >> 3), ch = (lane & 7) ^ ((row >> 1) & 7); vsrc0 = (unsigned)((h * 128 + row) * MP) * 2u + (unsigned)ch * 16u; }
    const char* Kc = (const char*)K; const char* Vc = (const char*)VT;
#define ATT_DMA(jt, stg) do { const int jj_ = (jt) < ntiles ? (jt) : ntiles - 1; const char* kt_ = Kc + (size_t)jj_ * (64 * 512 * 2); const char* vt_ = Vc + (size_t)jj_ * 128; \
        _Pragma("unroll") for (int i_ = 0; i_ < 4; ++i_) { \
            __builtin_amdgcn_global_load_lds((const unsigned*)(kt_ + (size_t)i_ * (16 * 512 * 2) + ksrc0), (LAS unsigned*)(lds + (stg) + (rg + 4 * i_) * 1024), 16, 0, 0); \
            __builtin_amdgcn_global_load_lds((const unsigned*)(vt_ + (size_t)i_ * (32 * (size_t)MP * 2) + vsrc0), (LAS unsigned*)(lds + (stg) + 16384 + (rg + 4 * i_) * 1024), 16, 0, 0); } } while (0)
#define WAITV0() asm volatile("s_waitcnt vmcnt(0)" ::: "memory")
#define BAR() do { asm volatile("s_waitcnt lgkmcnt(0)" ::: "memory"); __builtin_amdgcn_s_barrier(); asm volatile("" ::: "memory"); } while (0)
    const int Ak = r32 * 256 + ((c * 8 + hi) ^ (r32 & 15)) * 16, Bv = 16384 + r32 * 128 + (hi ^ ((r32 >> 1) & 7)) * 16;
#define KLD(stg, half, d0) (*(const LAS bf16x8*)(lds + (stg) + (half) * 8192 + (ak_ ^ ((d0) << 5))))
#define VLD(stg, cb, ks) (*(const LAS bf16x8*)(lds + (stg) + (cb) * 4096 + (bv_ ^ ((ks) << 5))))
#define ATT_QK(P0, P1, stg) do { int ak_ = Ak; asm volatile("" : "+v"(ak_)); P0 = f32x16{}; P1 = f32x16{}; \
        _Pragma("unroll") for (int d0 = 0; d0 < 4; ++d0) { const bf16x8 ka = KLD(stg, 0, d0), kc = KLD(stg, 1, d0); P0 = mfma32(ka, QFR(d0), P0); P1 = mfma32(kc, QFR(d0), P1); } } while (0)
#define EX2(P, r) do { P[r] = __builtin_amdgcn_exp2f(P[r] - mref); ls += P[r]; } while (0)
#define SBX() __builtin_amdgcn_sched_barrier(0)
#define S_BLOCK(k, P0, P1) do { \
        float mx = fmaxf(max16(P0), max16(P1)); \
        { const unsigned mu_ = __float_as_uint(mx); auto rr_ = __builtin_amdgcn_permlane32_swap(mu_, mu_, false, false); mx = fmaxf(__uint_as_float(rr_[0]), __uint_as_float(rr_[1])); } \
        if (__any(mx > mref + THR)) { const float nr = fmaxf(mref, mx), al = __builtin_amdgcn_exp2f(mref - nr); mref = nr; lsum *= al; \
            _Pragma("unroll") for (int cb = 0; cb < 4; ++cb) _Pragma("unroll") for (int r = 0; r < 16; ++r) o[cb][r] *= al; } \
        float ls = 0.f; \
        _Pragma("unroll") for (int r = 0; r < 16; ++r) EX2(P0, r); \
        pf0 = pack_bf8v(P0[0], P0[1], P0[2], P0[3], P0[4], P0[5], P0[6], P0[7]); pf1 = pack_bf8v(P0[8], P0[9], P0[10], P0[11], P0[12], P0[13], P0[14], P0[15]); \
        _Pragma("unroll") for (int r = 0; r < 16; ++r) EX2(P1, r); \
        pf2 = pack_bf8v(P1[0], P1[1], P1[2], P1[3], P1[4], P1[5], P1[6], P1[7]); pf3 = pack_bf8v(P1[8], P1[9], P1[10], P1[11], P1[12], P1[13], P1[14], P1[15]); \
        lsum += ls; \
        } while (0)
#define M_BLOCK(k, P0, P1) do { const int sv_ = ((k) & 3) * DSTG, sk_ = (((k) + 2) & 3) * DSTG; bf16x8 va[4], vb[4]; int ak_ = Ak, bv_ = Bv; asm volatile("" : "+v"(ak_), "+v"(bv_));     \
        _Pragma("unroll") for (int cb = 0; cb < 4; ++cb) { va[cb] = VLD(sv_, cb, 0); vb[cb] = VLD(sv_, cb, 1); } \
        SBX(); \
        _Pragma("unroll") for (int cb = 0; cb < 4; ++cb) { o[cb] = mfma32(va[cb], pf0, o[cb]); va[cb] = VLD(sv_, cb, 2); } \
        SBX(); \
        _Pragma("unroll") for (int cb = 0; cb < 4; ++cb) { o[cb] = mfma32(vb[cb], pf1, o[cb]); vb[cb] = VLD(sv_, cb, 3); } \
        SBX(); \
        _Pragma("unroll") for (int cb = 0; cb < 4; ++cb) { o[cb] = mfma32(va[cb], pf2, o[cb]); va[cb] = KLD(sk_, cb & 1, cb >> 1); } \
        SBX(); \
        _Pragma("unroll") for (int cb = 0; cb < 4; ++cb) { o[cb] = mfma32(vb[cb], pf3, o[cb]); vb[cb] = KLD(sk_, cb & 1, 2 + (cb >> 1)); } \
        SBX(); \
        P0 = f32x16{}; P1 = f32x16{}; \
        { const bf16x8 q1_ = QFR(1), q2_ = QFR(2), q3_ = QFR(3); \
        P0 = mfma32(va[0], qf0, P0); P1 = mfma32(va[1], qf0, P1); P0 = mfma32(va[2], q1_, P0); P1 = mfma32(va[3], q1_, P1); \
        P0 = mfma32(vb[0], q2_, P0); P1 = mfma32(vb[1], q2_, P1); P0 = mfma32(vb[2], q3_, P0); P1 = mfma32(vb[3], q3_, P1); } \
        SBX(); } while (0)
    f32x16 o[4];
#pragma unroll
    for (int cb = 0; cb < 4; ++cb) o[cb] = f32x16{};
    float mref = -INFINITY, lsum = 0.f;
    f32x16 e0, e1, d0s, d1s;
    bf16x8 pf0, pf1, pf2, pf3;
    if (c == 0) { ATT_DMA(0, 0); ATT_DMA(1, DSTG); ATT_DMA(2, 2 * DSTG); }
    WAITV0(); BAR();
    ATT_QK(e0, e1, 0); ATT_QK(d0s, d1s, DSTG);
    if (c == 0) {
        for (int k = 0; k < ntiles; k += 2) {
            if (k < myn) S_BLOCK(k, e0, e1);
            WAITV0(); BAR();
            ATT_DMA(k + 3, ((k + 3) & 3) * DSTG);
            if (k < myn) M_BLOCK(k, e0, e1);
            BAR();
            if (k + 1 < myn) S_BLOCK(k + 1, d0s, d1s);
            WAITV0(); BAR();
            ATT_DMA(k + 4, ((k + 4) & 3) * DSTG);
            if (k + 1 < myn) M_BLOCK(k + 1, d0s, d1s);
            BAR();
        }
        WAITV0(); BAR();
    } else {
        BAR();
        for (int k = 0; k < ntiles; k += 2) {
            if (k < myn) S_BLOCK(k, e0, e1);
            BAR();
            if (k < myn) M_BLOCK(k, e0, e1);
            BAR();
            if (k + 1 < myn) S_BLOCK(k + 1, d0s, d1s);
            BAR();
            if (k + 1 < myn) M_BLOCK(k + 1, d0s, d1s);
            BAR();
        }
    }
#undef QFR
#undef ATT_DMA
#undef WAITV0
#undef BAR
#undef KLD
#undef VLD
#undef ATT_QK
#undef EX2
#undef S_BLOCK
#undef SBX
#undef M_BLOCK
    lsum += __shfl_xor(lsum, 32);
    const float inv = 1.0f / lsum;
    int t2 = threadIdx.x; asm volatile("" : "+v"(t2));
    float lamv = __builtin_bit_cast(float, __builtin_amdgcn_readfirstlane(__builtin_bit_cast(int, lam))); asm volatile("" : "+s"(lamv));
    const int lane2 = t2 & 63, hi2 = lane2 >> 5, qrow2 = 128 * qb + 32 * rg + (lane2 & 31);
    LAS float* xb = (LAS float*)lds + (size_t)rg * 4096 + lane2;
    __syncthreads();
    if (c == 1) {
#pragma unroll
        for (int cb = 0; cb < 4; ++cb)
#pragma unroll
            for (int r = 0; r < 16; ++r) xb[(cb * 16 + r) * 64] = o[cb][r] * inv;
    }
    __syncthreads();
    if (c == 0) {
#pragma unroll
        for (int cb = 0; cb < 4; ++cb)
#pragma unroll
            for (int r = 0; r < 16; ++r) o[cb][r] = o[cb][r] * inv - lamv * xb[(cb * 16 + r) * 64];
        finish_store(o, sg, ATTN + (size_t)qrow2 * 512 + h * 128, hi2);
    }
    __syncthreads();
}

__device__ __forceinline__ void sample_block(const float* Kp, const float* Vp, const bf16x8 (&qf)[2][4], f32x16 (&o)[2][4], float (&mref)[2], float (&lsum)[2], int r32, int hi) {
    bf16x8 pf[2][2];
#pragma unroll
    for (int c = 0; c < 2; ++c) {
        f32x16 p = f32x16{};
#pragma unroll
        for (int d0 = 0; d0 < 4; ++d0) { const float* kp = Kp + (size_t)r32 * 512 + c * 64 + 16 * d0 + 8 * hi; const f32x4 a = *(const f32x4*)kp, b = *(const f32x4*)(kp + 4);
            p = mfma32(pack_bf8(a[0], a[1], a[2], a[3], b[0], b[1], b[2], b[3]), qf[c][d0], p); }
        float mx = max16(p); mx = fmaxf(mx, __shfl_xor(mx, 32));
        const float ms = mx;
        if (__any(ms > mref[c] + THR)) { const float nr = fmaxf(mref[c], ms), al = __builtin_amdgcn_exp2f(mref[c] - nr); mref[c] = nr; lsum[c] *= al;
#pragma unroll
            for (int cb = 0; cb < 4; ++cb)
#pragma unroll
                for (int r = 0; r < 16; ++r) o[c][cb][r] *= al; }
        float ls = 0.f;
#pragma unroll
        for (int r = 0; r < 16; ++r) { p[r] = __builtin_amdgcn_exp2f(p[r] - mref[c]); ls += p[r]; }
        lsum[c] += ls;
        pf[c][0] = pack_bf8(p[0], p[1], p[2], p[3], p[4], p[5], p[6], p[7]); pf[c][1] = pack_bf8(p[8], p[9], p[10], p[11], p[12], p[13], p[14], p[15]);
    }
#pragma unroll
    for (int cb = 0; cb < 4; ++cb)
#pragma unroll
        for (int ks = 0; ks < 2; ++ks) { const float* vp = Vp + (size_t)(16 * ks + 4 * hi) * 512 + cb * 32 + r32;
            const bf16x8 vf = pack_bf8(vp[0], vp[512], vp[1024], vp[1536], vp[8 * 512], vp[9 * 512], vp[10 * 512], vp[11 * 512]);
            o[0][cb] = mfma32(vf, pf[0][ks], o[0][cb]); o[1][cb] = mfma32(vf, pf[1][ks], o[1][cb]); }
}
__device__ __forceinline__ void sample_item(int b, int h, int sp, const bf16* Q, const float* ck, const float* cv, const float* nk, const float* nv, float* SP, LAS char* lds) {
    const int tid = threadIdx.x, lane = tid & 63, r32 = lane & 31, hi = lane >> 5, wid = __builtin_amdgcn_readfirstlane(tid >> 6);
    bf16x8 qf[2][4];
#pragma unroll
    for (int c = 0; c < 2; ++c)
#pragma unroll
        for (int d0 = 0; d0 < 4; ++d0) qf[c][d0] = *(const bf16x8*)(Q + (size_t)(MP + b * 32 + r32) * 512 + h * 128 + c * 64 + 16 * d0 + 8 * hi);
    f32x16 o[2][4];
#pragma unroll
    for (int c = 0; c < 2; ++c)
#pragma unroll
        for (int cb = 0; cb < 4; ++cb) o[c][cb] = f32x16{};
    float mref[2] = {-INFINITY, -INFINITY}, lsum[2] = {0.f, 0.f};
    const size_t key0 = (size_t)b * PASTL + sp * 1024 + wid * 128;
    for (int blk = 0; blk < 4; ++blk) sample_block(ck + (key0 + blk * 32) * 512 + h * 128, cv + (key0 + blk * 32) * 512 + h * 128, qf, o, mref, lsum, r32, hi);
    if (sp == 3 && wid == 7) sample_block(nk + (size_t)b * 32 * 512 + h * 128, nv + (size_t)b * 32 * 512 + h * 128, qf, o, mref, lsum, r32, hi);
    LAS float* mb = (LAS float*)(lds + 131072);
    LAS float* lb = mb + 1024;
    mb[(wid * 2 + 0) * 64 + lane] = mref[0]; mb[(wid * 2 + 1) * 64 + lane] = mref[1];
    __syncthreads();
    float Mx[2];
#pragma unroll
    for (int c = 0; c < 2; ++c) { float m = mb[c * 64 + lane];
#pragma unroll
        for (int w = 1; w < 8; ++w) m = fmaxf(m, mb[(w * 2 + c) * 64 + lane]);
        Mx[c] = m; const float sc = __builtin_amdgcn_exp2f(mref[c] - m); lsum[c] *= sc;
#pragma unroll
        for (int cb = 0; cb < 4; ++cb)
#pragma unroll
            for (int r = 0; r < 16; ++r) o[c][cb][r] *= sc;
        lb[(wid * 2 + c) * 64 + lane] = lsum[c]; }
#pragma unroll
    for (int st = 4; st >= 1; st >>= 1) {
        if (wid >= st && wid < 2 * st) { LAS float* sl = (LAS float*)lds + (size_t)(wid - st) * 8192 + lane;
#pragma unroll
            for (int c = 0; c < 2; ++c)
#pragma unroll
                for (int cb = 0; cb < 4; ++cb)
#pragma unroll
                    for (int r = 0; r < 16; ++r) sl[((c * 4 + cb) * 16 + r) * 64] = o[c][cb][r]; }
        __syncthreads();
        if (wid < st) { const LAS float* sl = (const LAS float*)lds + (size_t)wid * 8192 + lane;
#pragma unroll
            for (int c = 0; c < 2; ++c)
#pragma unroll
                for (int cb = 0; cb < 4; ++cb)
#pragma unroll
                    for (int r = 0; r < 16; ++r) o[c][cb][r] += sl[((c * 4 + cb) * 16 + r) * 64]; }
        __syncthreads();
    }
    if (wid == 0) {
#pragma unroll
        for (int c = 0; c < 2; ++c) { float l = 0.f;
#pragma unroll
            for (int w = 0; w < 8; ++w) l += lb[(w * 2 + c) * 64 + lane];
            l += __shfl_xor(l, 32);
            float* dst = SP + (size_t)(((b * 4 + h) * 4 + sp) * 2 + c) * SPART_FLOATS + lane;
#pragma unroll
            for (int cb = 0; cb < 4; ++cb)
#pragma unroll
                for (int r = 0; r < 16; ++r) dst[(cb * 16 + r) * 64] = o[c][cb][r];
            dst[4096] = Mx[c]; dst[4096 + 64] = l; }
    }
    __syncthreads();
}
__device__ __forceinline__ void sample_combine(int bh, const float* SP, float lam, const float* sg, bf16* ATTN, int lane) {
    const int r32 = lane & 31, hi = lane >> 5;
    float sc[2][4];
#pragma unroll
    for (int c = 0; c < 2; ++c) {
        const float* src = SP + (size_t)((bh * 4) * 2 + c) * SPART_FLOATS + lane;
        float ms[4], m = -INFINITY, l = 0.f;
#pragma unroll
        for (int s = 0; s < 4; ++s) { ms[s] = src[(size_t)s * 2 * SPART_FLOATS + 4096]; m = fmaxf(m, ms[s]); }
#pragma unroll
        for (int s = 0; s < 4; ++s) { sc[c][s] = __builtin_amdgcn_exp2f(ms[s] - m); l += sc[c][s] * src[(size_t)s * 2 * SPART_FLOATS + 4096 + 64]; }
        const float inv = (c == 0 ? 1.0f : -lam) / l;
#pragma unroll
        for (int s = 0; s < 4; ++s) sc[c][s] *= inv;
    }
    f32x16 o[4];
#pragma unroll
    for (int cb = 0; cb < 4; ++cb) { o[cb] = f32x16{};
#pragma unroll
        for (int c = 0; c < 2; ++c)
#pragma unroll
            for (int s = 0; s < 4; ++s) { const float* src = SP + (size_t)((bh * 4 + s) * 2 + c) * SPART_FLOATS + lane;
#pragma unroll
                for (int r = 0; r < 16; ++r) o[cb][r] += sc[c][s] * src[(cb * 16 + r) * 64]; } }
    const int b = bh >> 2, h = bh & 3;
    finish_store(o, sg, ATTN + (size_t)(MP + b * 32 + r32) * 512 + h * 128, hi);
}
}

__device__ __forceinline__ void pool_phase(const bf16* UPOOL, const float* state, bf16* MIXED, int gtid, int nthr) {
    for (int it = gtid; it < M * 64; it += nthr) {
        const int row = it >> 6, cg8 = it & 63, c0 = cg8 * 8, w = 2 << (cg8 >> 4);
        float s[8] = {0.f, 0.f, 0.f, 0.f, 0.f, 0.f, 0.f, 0.f}, self[8]; float cnt;
        { const u32x4 v = *(const u32x4*)(UPOOL + (size_t)row * 512 + c0); self[0] = pg8::bf_lo(v.x); self[1] = pg8::bf_hi(v.x); self[2] = pg8::bf_lo(v.y); self[3] = pg8::bf_hi(v.y);
          self[4] = pg8::bf_lo(v.z); self[5] = pg8::bf_hi(v.z); self[6] = pg8::bf_lo(v.w); self[7] = pg8::bf_hi(v.w); }
        if (row < MP) { const int lo = row - w + 1 < 0 ? 0 : row - w + 1; cnt = (float)(row - lo + 1);
            for (int r = lo; r <= row; ++r) { const u32x4 v = *(const u32x4*)(UPOOL + (size_t)r * 512 + c0);
                s[0] += pg8::bf_lo(v.x); s[1] += pg8::bf_hi(v.x); s[2] += pg8::bf_lo(v.y); s[3] += pg8::bf_hi(v.y); s[4] += pg8::bf_lo(v.z); s[5] += pg8::bf_hi(v.z); s[6] += pg8::bf_lo(v.w); s[7] += pg8::bf_hi(v.w); }
        } else { const int b = (row - MP) >> 5, t = (row - MP) & 31; cnt = (float)w;
            for (int e = 15 + t - w + 1; e <= 15 + t; ++e) {
                if (e < 15) { const float* sp = state + (size_t)(b * 15 + e) * 512 + c0; const f32x4 a = *(const f32x4*)sp, bq = *(const f32x4*)(sp + 4);
                    s[0] += a[0]; s[1] += a[1]; s[2] += a[2]; s[3] += a[3]; s[4] += bq[0]; s[5] += bq[1]; s[6] += bq[2]; s[7] += bq[3]; }
                else { const u32x4 v = *(const u32x4*)(UPOOL + (size_t)(MP + b * 32 + e - 15) * 512 + c0);
                    s[0] += pg8::bf_lo(v.x); s[1] += pg8::bf_hi(v.x); s[2] += pg8::bf_lo(v.y); s[3] += pg8::bf_hi(v.y); s[4] += pg8::bf_lo(v.z); s[5] += pg8::bf_hi(v.z); s[6] += pg8::bf_lo(v.w); s[7] += pg8::bf_hi(v.w); } } }
        const float ic = 1.0f / cnt; u32x4 o;
        o.x = pk2(s[0] * ic - self[0], s[1] * ic - self[1]); o.y = pk2(s[2] * ic - self[2], s[3] * ic - self[3]); o.z = pk2(s[4] * ic - self[4], s[5] * ic - self[5]); o.w = pk2(s[6] * ic - self[6], s[7] * ic - self[7]);
        *(u32x4*)(MIXED + (size_t)row * 512 + c0) = o;
    }
}

#define XB_TMO      128
#define XB_XCNT(j)  (256  + 64 * (j))
#define XB_XSUB(j)  (1280 + 64 * (j))
#define XB_XGEN(j)  (2304 + 64 * (j))
#define XB_TOP      3328
#define XB_TOPGEN   3392
#define XCD_BAR_WORDS 3456
#define XB_SPIN_CAP (1u << 18)

__device__ __forceinline__ unsigned xb_ld(unsigned* p)              { return __hip_atomic_load(p, __ATOMIC_RELAXED, __HIP_MEMORY_SCOPE_AGENT); }
__device__ __forceinline__ unsigned xb_add(unsigned* p, unsigned v) { return __hip_atomic_fetch_add(p, v, __ATOMIC_RELAXED, __HIP_MEMORY_SCOPE_AGENT); }
__device__ __forceinline__ unsigned xb_xcc_id() { return (unsigned)__builtin_amdgcn_s_getreg((3 << 11) | 20) & 0xFu; }
#define XB_SPIN(cond, bar) do { unsigned _sp = 0; while (cond) { __builtin_amdgcn_s_sleep(1); \
    if ((++_sp & 255u) == 0u) { if (xb_ld(&(bar)[XB_TMO])) break; if (_sp > XB_SPIN_CAP) { atomicAdd(&(bar)[XB_TMO], 1u); break; } } } } while (0)

struct XcdBarrier {
    unsigned* bar; unsigned x;
    volatile LAS unsigned* st;
};

__device__ __forceinline__ XcdBarrier xcd_barrier_post(unsigned* bar, volatile LAS unsigned* st) {
    XcdBarrier b; b.bar = bar; b.x = xb_xcc_id(); b.st = st;
    if (threadIdx.x == 0) (void)xb_add(&bar[XB_XCNT(b.x)], 1u);
    return b;
}
__device__ __forceinline__ void xcd_barrier_complete(unsigned* bar, unsigned x, unsigned& nloc, unsigned& nx) {
    const unsigned G = gridDim.x * gridDim.y * gridDim.z;
    unsigned sum, cnt, mine, sp = 0u;
    for (;;) {
        sum = 0u; cnt = 0u; mine = 0u;
#pragma unroll
        for (unsigned j = 0; j < 16; ++j) { const unsigned c = xb_ld(&bar[XB_XCNT(j)]); sum += c; cnt += (c > 0u) ? 1u : 0u; mine = (j == x) ? c : mine; }
        if (sum == G) break;
        __builtin_amdgcn_s_sleep(1);
        if ((++sp & 255u) == 0u) { if (xb_ld(&bar[XB_TMO])) break; if (sp > XB_SPIN_CAP) { atomicAdd(&bar[XB_TMO], 1u); break; } }
    }
    nloc = mine > 0u ? mine : 1u; nx = cnt > 0u ? cnt : 1u;
}

__device__ __forceinline__ void xcd_barrier(const XcdBarrier& b) {
    asm volatile("s_waitcnt vmcnt(0)" ::: "memory");
    __syncthreads();
    if (threadIdx.x == 0) {
        unsigned* bar = b.bar;
        __builtin_amdgcn_s_waitcnt(0);
        unsigned nloc = b.st[0], nx = b.st[1];
        if (nloc == 0u) { xcd_barrier_complete(bar, b.x, nloc, nx); b.st[0] = nloc; b.st[1] = nx; }
        const unsigned old = xb_add(&bar[XB_XSUB(b.x)], 1u);
        const unsigned gen = old / nloc;
        if (old + 1u == (gen + 1u) * nloc) {
            __builtin_amdgcn_fence(__ATOMIC_RELEASE, "agent");
            asm volatile("s_waitcnt vmcnt(0)" ::: "memory");
            const unsigned og = xb_add(&bar[XB_TOP], 1u);
            const unsigned tg = og / nx;
            if (og + 1u == (tg + 1u) * nx) xb_add(&bar[XB_TOPGEN], 1u);
            else XB_SPIN(xb_ld(&bar[XB_TOPGEN]) == tg, bar);
            __builtin_amdgcn_fence(__ATOMIC_ACQUIRE, "agent");
            xb_add(&bar[XB_XGEN(b.x)], 1u);
            asm volatile("s_waitcnt vmcnt(0)" ::: "memory");
        } else {
            XB_SPIN(xb_ld(&bar[XB_XGEN(b.x)]) == gen, bar);
            __builtin_amdgcn_fence(__ATOMIC_ACQUIRE, "agent");
            asm volatile("s_waitcnt vmcnt(0)" ::: "memory");
        }
    }
    __syncthreads();
}

struct Args { const float* in[26]; float* out; unsigned char* ws; double rc[8]; int ph_lo, ph_hi; };
__global__ void __launch_bounds__(512, 2) fwd_mega(Args a) {
    extern __shared__ __attribute__((aligned(16))) unsigned char lds_raw[];
    LAS unsigned char* lds = (LAS unsigned char*)lds_raw;
    cg::grid_group grid = cg::this_grid();
    const int tid = threadIdx.x, lane = tid & 63, wid = __builtin_amdgcn_readfirstlane(tid >> 6);
    const int G = gridDim.x, gw = blockIdx.x * 8 + wid, NGW = G * 8;
    unsigned char* ws = a.ws;
    bf16 *WGU1 = (bf16*)(ws + WS_WGU1), *WD1 = (bf16*)(ws + WS_WD1), *WIN = (bf16*)(ws + WS_WIN), *WC = (bf16*)(ws + WS_WC), *WBA = (bf16*)(ws + WS_WBA), *WOUT = (bf16*)(ws + WS_WOUT), *WGU2 = (bf16*)(ws + WS_WGU2), *WD2 = (bf16*)(ws + WS_WD2);
    bf16 *XN = (bf16*)(ws + WS_XN), *HID = (bf16*)(ws + WS_HID), *UPOOL = (bf16*)(ws + WS_UPOOL), *QB = (bf16*)(ws + WS_Q), *KB = (bf16*)(ws + WS_K), *VT = (bf16*)(ws + WS_VT), *GATES = (bf16*)(ws + WS_GATES), *MIXED = (bf16*)(ws + WS_MIXED), *ATTN = (bf16*)(ws + WS_ATTN);
    float *D = (float*)(ws + WS_D), *H = (float*)(ws + WS_H), *SPART = (float*)(ws + WS_SPART), *DP = (float*)(ws + WS_DP);
    const float *xp = a.in[0], *xs = a.in[1];
    volatile LAS unsigned* MISC = (volatile LAS unsigned*)(lds + LDS_BYTES - 64);
    if (tid < 16) MISC[tid] = 0u;
    __syncthreads();
    unsigned* barw = (unsigned*)ws;
    XcdBarrier bar = xcd_barrier_post(barw, MISC);
    if (a.ph_lo < 0) grid.sync();
    const int lo = a.ph_lo, hi_ = a.ph_hi;
#define IN(k) (lo <= (k) && (k) < hi_)
#define REPEAT(k) for (int rep_ = 0; rep_ < 1 + ((REP_MASK >> (k)) & 1); ++rep_, (rep_ < 1 + ((REP_MASK >> (k)) & 1) ? grid.sync() : (void)0))
#define SEAM(k) do { if (IN(k) && IN((k) + 1)) xcd_barrier(bar); } while (0)

    for (int rz_ = 0; rz_ < SYNC_REP; ++rz_) grid.sync();
    if (IN(0)) REPEAT(0) {
        LAS float* scr = (LAS float*)(lds + wid * 16384);
        transpose_mat(a.in[7], DMODEL, NGU, WGU1, true, gw, NGW, scr, lane);
        transpose_mat(a.in[8], DFF, DMODEL, WD1, false, gw, NGW, scr, lane);
        transpose_mat(a.in[11], DMODEL, 4096, WIN, false, gw, NGW, scr, lane);
        transpose_mat(a.in[20], 512, DMODEL, WBA, false, gw, NGW, scr, lane);
        transpose_mat(a.in[21], DMODEL, DMODEL, WOUT, false, gw, NGW, scr, lane);
        transpose_mat(a.in[24], DMODEL, NGU, WGU2, true, gw, NGW, scr, lane);
        transpose_mat(a.in[25], DFF, DMODEL, WD2, false, gw, NGW, scr, lane);
        { const float *pw = a.in[12], *psc = a.in[13], *wbp = a.in[19];
          for (int it = gw; it < 64 * 16; it += NGW) { const int kg = it >> 4, e = (it & 15) * 64 + lane, g = kg >> 4, cbase = (kg & 15) * 8;
              float acc8[8] = {0.f, 0.f, 0.f, 0.f, 0.f, 0.f, 0.f, 0.f};
              for (int j = 0; j < 128; ++j) { const float wv = wbp[(size_t)(g * 128 + j) * DMODEL + e] * psc[g * 128 + j];
#pragma unroll
                  for (int i = 0; i < 8; ++i) acc8[i] += pw[(size_t)(g * 128 + cbase + i) * 128 + j] * wv; }
              u32x4 o; o.x = pk2(acc8[0], acc8[1]); o.y = pk2(acc8[2], acc8[3]); o.z = pk2(acc8[4], acc8[5]); o.w = pk2(acc8[6], acc8[7]);
              *(u32x4*)(WC + (size_t)e * 512 + g * 128 + cbase) = o; } }
        for (int row = gw; row < M; row += NGW) { const float* xr = xrow_ptr(xp, xs, row); f32x4 v[4];
#pragma unroll
            for (int j = 0; j < 4; ++j) v[j] = *((const f32x4*)xr + lane + 64 * j);
            norm_row_bf16(v, a.in[5], XN + (size_t)row * DMODEL, lane); }
    }
    SEAM(0);
    if (IN(1)) REPEAT(1) { pg8::Gemm g{XN, WGU1, M, NGU, DMODEL}; pg8::StaticOrder S; S.init(M, NGU, G, (int)blockIdx.x, g.K); pg8::EpiSwiglu E{HID, DFF};
        pg8::gemm_phase<pg8::EpiSwiglu, pg8::StaticOrder, true, true>(lds, g, S, E); }
    SEAM(1);
    if (IN(2)) REPEAT(2) { pg8::Gemm g{HID, WD1, M, DMODEL, DFF}; pg8::SplitOrder S; S.init(DMODEL, G, (int)blockIdx.x, g.K, 11); pg8::EpiF32 E{D, DMODEL, DP};
        pg8::gemm_phase<pg8::EpiF32, pg8::SplitOrder, true, true>(lds, g, S, E); }
    SEAM(2);
    if (IN(3)) REPEAT(3) resnorm_rows(xp, xs, nullptr, D, DP, 11, 0.5f, a.in[6], H, a.in[9], XN, gw, NGW, lane);
    SEAM(3);
    if (IN(4)) REPEAT(4) { pg8::Gemm g{XN, WIN, M, 4096, DMODEL}; pg8::StaticOrder S; S.init(M, 4096, G, (int)blockIdx.x, g.K);
        pg8::EpiWin E{UPOOL, QB, KB, VT, GATES, a.out, {a.rc[0], a.rc[1], a.rc[2], a.rc[3], a.rc[4], a.rc[5], a.rc[6], a.rc[7]}};
        pg8::gemm_phase<pg8::EpiWin, pg8::StaticOrder, true, true>(lds, g, S, E); }
    SEAM(4);
    if (IN(5)) REPEAT(5) {
        for (int rq_ = 0; rq_ < POOL_REP; ++rq_) pool_phase(UPOOL, a.in[4], MIXED, blockIdx.x * 512 + tid, G * 512);
        const float lam = compute_lam(a.in[14], a.in[15], a.in[16], a.in[17], lane);
        for (int rs_ = 0; rs_ < SAMP_REP; ++rs_)
        for (int it = blockIdx.x; it < 256; it += G) att::sample_item(it >> 4, (it >> 2) & 3, it & 3, QB, a.in[2], a.in[3], a.out + OFF_KS, a.out + OFF_VS, SPART, (LAS char*)lds);
        for (int rp_ = 0; rp_ < ATT_REP; ++rp_)
        for (int p = blockIdx.x; p < 256; p += G) { const int h = p >> 6, s = p & 63;
            att::prompt_unit(h, 127 - s, QB, KB, VT, ATTN, lam, a.in[18], (LAS char*)lds);
            att::prompt_unit(h, s, QB, KB, VT, ATTN, lam, a.in[18], (LAS char*)lds); }
    }
    SEAM(5);
    if (IN(6)) REPEAT(6) { const float lam = compute_lam(a.in[14], a.in[15], a.in[16], a.in[17], lane);
        for (int bh = gw; bh < 64; bh += NGW) att::sample_combine(bh, SPART, lam, a.in[18], ATTN, lane); }
    SEAM(6);
    if (IN(7)) REPEAT(7) { pg8::Gemm g{MIXED, WC, M, DMODEL, 512}; pg8::StaticOrder S; S.init(M, DMODEL, G, (int)blockIdx.x, g.K); pg8::EpiMergeA E{GATES, D};
        pg8::gemm_phase<pg8::EpiMergeA, pg8::StaticOrder, true, true>(lds, g, S, E); }
    if (IN(8)) REPEAT(8) { pg8::Gemm g{ATTN, WBA, M, DMODEL, 512}; pg8::StaticOrder S; S.init(M, DMODEL, G, (int)blockIdx.x, g.K); pg8::EpiMergeB E{GATES, D, XN};
        pg8::gemm_phase<pg8::EpiMergeB, pg8::StaticOrder, true, true>(lds, g, S, E); }
    SEAM(8);
    if (IN(9)) REPEAT(9) { pg8::Gemm g{XN, WOUT, M, DMODEL, DMODEL}; pg8::SplitOrder S; S.init(DMODEL, G, (int)blockIdx.x, g.K, 4); pg8::EpiF32 E{D, DMODEL, DP};
        pg8::gemm_phase<pg8::EpiF32, pg8::SplitOrder, true, true>(lds, g, S, E); }
    SEAM(9);
    if (IN(10)) REPEAT(10) resnorm_rows(xp, xs, H, D, DP, 4, 1.0f, a.in[10], H, a.in[22], XN, gw, NGW, lane);
    SEAM(10);
    if (IN(11)) REPEAT(11) { pg8::Gemm g{XN, WGU2, M, NGU, DMODEL}; pg8::StaticOrder S; S.init(M, NGU, G, (int)blockIdx.x, g.K); pg8::EpiSwiglu E{HID, DFF};
        pg8::gemm_phase<pg8::EpiSwiglu, pg8::StaticOrder, true, true>(lds, g, S, E); }
    SEAM(11);
    if (IN(12)) REPEAT(12) { pg8::Gemm g{HID, WD2, M, DMODEL, DFF}; pg8::SplitOrder S; S.init(DMODEL, G, (int)blockIdx.x, g.K, 11); pg8::EpiF32 E{D, DMODEL, DP};
        pg8::gemm_phase<pg8::EpiF32, pg8::SplitOrder, true, true>(lds, g, S, E); }
    SEAM(12);
    if (IN(13)) REPEAT(13) resnorm_rows(xp, xs, H, D, DP, 11, 0.5f, a.in[23], a.out, nullptr, nullptr, gw, NGW, lane);
#undef IN
#undef SEAM
}

#ifndef N_LAUNCH_PER_PHASE
#define N_LAUNCH_PER_PHASE 0
#endif
extern "C" void kernel_launch(void* const* d_in, const int* in_sizes, int n_in, void* d_out, int out_size, void* d_ws, size_t ws_size, hipStream_t stream) {
    static int grid = 0;
    if (grid == 0) {
        if (n_in != 26 || (size_t)out_size != OUT_TOTAL || ws_size < WS_END) { fprintf(stderr, "kernel_launch: unexpected sizes n_in %d out %d ws %zu\n", n_in, out_size, ws_size); grid = -1; return; }
        int dev = 0, cus = 0, per_cu = 0;
        hipGetDevice(&dev); hipDeviceGetAttribute(&cus, hipDeviceAttributeMultiprocessorCount, dev);
        hipFuncSetAttribute((const void*)fwd_mega, hipFuncAttributeMaxDynamicSharedMemorySize, LDS_BYTES);
        hipOccupancyMaxActiveBlocksPerMultiprocessor(&per_cu, (const void*)fwd_mega, 512, LDS_BYTES);
        if (per_cu < 1) { fprintf(stderr, "kernel_launch: occupancy query says %d\n", per_cu); per_cu = 1; }
        (void)hipGetLastError();
        grid = cus * (per_cu > 1 ? 1 : per_cu);
    }
    if (grid < 0) return;
    Args a{};
    for (int i = 0; i < 26; ++i) a.in[i] = (const float*)d_in[i];
    a.out = (float*)d_out; a.ws = (unsigned char*)d_ws;
    for (int i = 0; i < 8; ++i) a.rc[i] = pow(500000.0, -(double)i / 8.0) / (2.0 * M_PI);
#if N_LAUNCH_PER_PHASE
    for (int p = 0; p < NPH; ++p) { a.ph_lo = p; a.ph_hi = p + 1; hipLaunchKernelGGL(fwd_mega, dim3(grid), dim3(512), LDS_BYTES, stream, a); }
#else
    a.ph_lo = 0; a.ph_hi = NPH;
    if (hipMemsetAsync(d_ws, 0, XCD_BAR_WORDS * sizeof(unsigned), stream) != hipSuccess) { fprintf(stderr, "kernel_launch: memset of the barrier words failed\n"); return; }
    void* args[] = {&a};
    hipError_t e = hipLaunchCooperativeKernel((const void*)fwd_mega, dim3(grid), dim3(512), args, LDS_BYTES, stream);
    if (e != hipSuccess) fprintf(stderr, "cooperative launch failed: %s (grid %d)\n", hipGetErrorString(e), grid);
#endif
}
```

```cpp
#include <hip/hip_runtime.h>
#include <hip/hip_cooperative_groups.h>
#include <cstdio>
#include <cstdint>
#include <cmath>
namespace cg = cooperative_groups;
namespace pg8 {
#define PG8_LAS __attribute__((address_space(3)))
typedef unsigned short bf16_t;
typedef short bf16x8 __attribute__((ext_vector_type(8)));
typedef float f32x4 __attribute__((ext_vector_type(4)));
typedef unsigned u32x4 __attribute__((ext_vector_type(4)));
constexpr int BM = 256, BK = 64, HALF = 128, HTB = HALF * BK * 2  , STAGE_BYTES = 8 * HTB, NXCD = 8, WGM = 8;

__host__ __device__ __forceinline__ int lds_byte(int r, int c) { const int st = (r >> 4) * 2 + (c >> 5), rr = r & 15, cc = c & 31, ob = rr * 64 + cc * 2; return st * 1024 + (ob ^ (((ob >> 9) & 1) << 5)); }
__host__ __device__ __forceinline__ void stage_rc(int b, int& R, int& C) { const int st = b / 1024, sb = b % 1024, swz = sb ^ (((sb >> 9) & 1) << 5); R = (st >> 1) * 16 + swz / 64; C = (st & 1) * 32 + (swz % 64) / 2; }
__host__ __device__ __forceinline__ int perm32(int rho) { const int n = rho >> 4, i = rho & 15; return 8 * (i >> 2) + 4 * n + (i & 3); }

struct Unit { int pm, pn, ks; };
struct Gemm { const bf16_t* A; const bf16_t* Bt; int M, N, K; };

struct StaticOrder {
    int nM, nN, nwg, G, c, ntk;
    __host__ __device__ void init(int M, int N, int G_, int c_, int K_) { nM = M / BM; nN = N / BM; nwg = nM * nN; G = G_; c = c_; ntk = K_ / BK; }
    __host__ __device__ bool next(int i, Unit& u) const {
        const long L = (long)i * G + c; if (L >= nwg) return false;
        int wgid = (int)L; { const int q = nwg / NXCD, r = nwg % NXCD, xcd = wgid % NXCD, off = wgid / NXCD; wgid = (xcd < r ? xcd * (q + 1) : r * (q + 1) + (xcd - r) * q) + off; }
        const int nig = WGM * nN, gid = wgid / nig, fm = gid * WGM, gsz = (nM - fm) < WGM ? (nM - fm) : WGM;
        u.pm = fm + ((wgid % nig) % gsz); u.pn = (wgid % nig) / gsz; u.ks = 0; return true;
    }
    __device__ __forceinline__ void a_ready(const Unit&) const {}
    __device__ __forceinline__ void done(const Unit&) const {}
    __device__ __forceinline__ int nt(const Unit&) const { return ntk; }
    __device__ __forceinline__ int kt0(const Unit&) const { return 0; }
};
struct SplitOrder {
    StaticOrder so; int S, ntk, c;
    __host__ __device__ void init(int N, int G_, int c_, int K_, int S_) { so.init(64 * BM, N, G_, c_, K_); S = S_; ntk = K_ / BK; c = c_; }
    __host__ __device__ bool next(int i, Unit& u) const {
        const int L = i * so.G + c;
        if (L >= so.nwg + 8 * S) return false;
        Unit t; t.pm = 0; t.pn = 0; t.ks = 0; (void)so.next(i, t);
        const int j = L - so.nwg, tile = j / S, sp = (int)(L >= so.nwg);
        u.pm = sp ? 64 + (tile >> 2) : t.pm; u.pn = sp ? (tile & 3) : t.pn; u.ks = sp ? j - tile * S : 0; return true;
    }
    __device__ __forceinline__ void a_ready(const Unit&) const {}
    __device__ __forceinline__ void done(const Unit&) const {}
    __device__ __forceinline__ int nt(const Unit& u) const { const int sp = (int)(u.pm >= 64), nts = ntk / S; return ntk - sp * (ntk - nts); }
    __device__ __forceinline__ int kt0(const Unit& u) const { const int sp = (int)(u.pm >= 64); return sp * u.ks * (ntk / S); }
};

__device__ __forceinline__ unsigned cvt_pk_bf16(float lo, float hi) { unsigned r; asm volatile("v_cvt_pk_bf16_f32 %0, %1, %2" : "=v"(r) : "v"(lo), "v"(hi)); return r; }
typedef float f32x2 __attribute__((ext_vector_type(2)));
__device__ __forceinline__ float sigm(float x) { return __builtin_amdgcn_rcpf(1.f + __builtin_amdgcn_exp2f(-1.4426950408889634f * x)); }
__device__ __forceinline__ float bf_lo(unsigned w) { return __uint_as_float(w << 16); }
__device__ __forceinline__ float bf_hi(unsigned w) { return __uint_as_float(w & 0xffff0000u); }
__device__ __forceinline__ u32x4 pack8(const f32x4 a, const f32x4 b) { u32x4 w; w.x = cvt_pk_bf16(a[0], a[1]); w.y = cvt_pk_bf16(a[2], a[3]); w.z = cvt_pk_bf16(b[0], b[1]); w.w = cvt_pk_bf16(b[2], b[3]); return w; }

struct EpiSwiglu {
    static constexpr bool PERM = true, AFTER_DRAIN = false;
    bf16_t* O; int ldc;
    __device__ __forceinline__ void operator()(const f32x4 (&acc)[2][2][4][2], const Unit& u, int wr, int wc, int fr, int fq) const {
        const int row0 = u.pm * BM + wr * 64 + fr, col0 = u.pn * HALF + wc * 32 + 8 * fq;
#pragma unroll
        for (int ai = 0; ai < 2; ++ai)
#pragma unroll
            for (int m = 0; m < 4; ++m) {
                f32x4 h0, h1;
#pragma unroll
                for (int i = 0; i < 4; ++i) { const float g0 = acc[ai][0][m][0][i], g1 = acc[ai][0][m][1][i]; h0[i] = g0 * sigm(g0) * acc[ai][1][m][0][i]; h1[i] = g1 * sigm(g1) * acc[ai][1][m][1][i]; }
                *(u32x4*)(O + (size_t)(row0 + ai * HALF + m * 16) * ldc + col0) = pack8(h0, h1);
            }
    }
};
struct EpiF32 {
    static constexpr bool PERM = false, AFTER_DRAIN = false;
    float* O; int ldc; float* DP;
    __device__ __forceinline__ void operator()(const f32x4 (&acc)[2][2][4][2], const Unit& u, int wr, int wc, int fr, int fq) const {
        const int row0 = u.pm * BM + wr * 64 + fr, col0 = u.pn * BM + wc * 32 + 4 * fq;
        float* base = (DP && u.pm >= 64) ? DP + ((size_t)u.ks * 512 - 16384) * 1024 : O;
#pragma unroll
        for (int ai = 0; ai < 2; ++ai)
#pragma unroll
            for (int m = 0; m < 4; ++m) { float* rp = base + (size_t)(row0 + ai * HALF + m * 16) * ldc + col0;
#pragma unroll
                for (int bj = 0; bj < 2; ++bj)
#pragma unroll
                    for (int n = 0; n < 2; ++n) *(f32x4*)(rp + bj * HALF + n * 16) = acc[ai][bj][m][n]; }
    }
};
struct EpiMergeA {
    static constexpr bool PERM = true, AFTER_DRAIN = false;
    const bf16_t* G; float* MG;
    __device__ __forceinline__ void operator()(const f32x4 (&acc)[2][2][4][2], const Unit& u, int wr, int wc, int fr, int fq) const {
        const int row0 = u.pm * BM + wr * 64 + fr, col0 = u.pn * BM + wc * 32 + 8 * fq;
#pragma unroll
        for (int ai = 0; ai < 2; ++ai)
#pragma unroll
            for (int m = 0; m < 4; ++m) { const size_t row = (size_t)(row0 + ai * HALF + m * 16);
#pragma unroll
                for (int bj = 0; bj < 2; ++bj) { const int c0 = col0 + bj * HALF; const u32x4 g = *(const u32x4*)(G + row * 2048 + c0);
                    const f32x4 a = acc[ai][bj][m][0], b = acc[ai][bj][m][1];
                    f32x4 o0 = {a[0] * bf_lo(g.x), a[1] * bf_hi(g.x), a[2] * bf_lo(g.y), a[3] * bf_hi(g.y)}, o1 = {b[0] * bf_lo(g.z), b[1] * bf_hi(g.z), b[2] * bf_lo(g.w), b[3] * bf_hi(g.w)};
                    *(f32x4*)(MG + row * 1024 + c0) = o0; *(f32x4*)(MG + row * 1024 + c0 + 4) = o1; } }
    }
};
struct EpiMergeB {
    static constexpr bool PERM = true, AFTER_DRAIN = false;
    const bf16_t* G; const float* MG; bf16_t* O;
    __device__ __forceinline__ void operator()(const f32x4 (&acc)[2][2][4][2], const Unit& u, int wr, int wc, int fr, int fq) const {
        const int row0 = u.pm * BM + wr * 64 + fr, col0 = u.pn * BM + wc * 32 + 8 * fq;
#pragma unroll
        for (int ai = 0; ai < 2; ++ai)
#pragma unroll
            for (int m = 0; m < 4; ++m) { const size_t row = (size_t)(row0 + ai * HALF + m * 16);
#pragma unroll
                for (int bj = 0; bj < 2; ++bj) { const int c0 = col0 + bj * HALF; const u32x4 g = *(const u32x4*)(G + row * 2048 + 1024 + c0);
                    const f32x4 m0 = *(const f32x4*)(MG + row * 1024 + c0), m1 = *(const f32x4*)(MG + row * 1024 + c0 + 4);
                    const f32x4 a = acc[ai][bj][m][0], b = acc[ai][bj][m][1];
                    f32x4 o0 = {m0[0] + a[0] * bf_lo(g.x), m0[1] + a[1] * bf_hi(g.x), m0[2] + a[2] * bf_lo(g.y), m0[3] + a[3] * bf_hi(g.y)};
                    f32x4 o1 = {m1[0] + b[0] * bf_lo(g.z), m1[1] + b[1] * bf_hi(g.z), m1[2] + b[2] * bf_lo(g.w), m1[3] + b[3] * bf_hi(g.w)};
                    *(u32x4*)(O + row * 1024 + c0) = pack8(o0, o1); } }
    }
};
constexpr int EW_MP = 16384;
constexpr size_t EW_OFF_KP = 17301504, EW_OFF_VP = 25690112, EW_OFF_PP = 34078720, EW_OFF_KS = 34086400, EW_OFF_VS = 34348544, EW_OFF_PS = 34610688;
struct EpiWin {
    static constexpr bool PERM = true, AFTER_DRAIN = false;
    bf16_t *UPOOL, *Q, *K, *VT, *GATES; float* out; double rc[8];
    __device__ __forceinline__ void operator()(const f32x4 (&acc)[2][2][4][2], const Unit& u, int wr, int wc, int fr, int fq) const {
        const int pn = u.pn, row0 = u.pm * BM + wr * 64 + fr, cl = wc * 32 + 8 * fq;
        if (pn < 2) {
#pragma unroll
            for (int ai = 0; ai < 2; ++ai)
#pragma unroll
                for (int m = 0; m < 4; ++m) { const int row = row0 + ai * HALF + m * 16;
                    long po = -1;
                    if (row >= EW_MP - 15 && row < EW_MP) po = (long)EW_OFF_PP + (long)(row - (EW_MP - 15)) * 512;
                    else if (row >= EW_MP) { const int t = (row - EW_MP) & 31, b = (row - EW_MP) >> 5; if (t >= 17) po = (long)EW_OFF_PS + (long)(b * 15 + t - 17) * 512; }
#pragma unroll
                    for (int bj = 0; bj < 2; ++bj) { const int c0 = pn * BM + bj * HALF + cl;
                        *(u32x4*)(UPOOL + (size_t)row * 512 + c0) = pack8(acc[ai][bj][m][0], acc[ai][bj][m][1]);
                        if (po >= 0) { *(f32x4*)(out + po + c0) = acc[ai][bj][m][0]; *(f32x4*)(out + po + c0 + 4) = acc[ai][bj][m][1]; } } }
        } else if (pn < 6) {
            const bool is_k = pn >= 4; const bool ropew = (wc & 1) == 0;
#pragma unroll
            for (int ai = 0; ai < 2; ++ai)
#pragma unroll
                for (int m = 0; m < 4; ++m) { const int row = row0 + ai * HALF + m * 16;
                    f32x4 v[2][2] = {{acc[ai][0][m][0], acc[ai][0][m][1]}, {acc[ai][1][m][0], acc[ai][1][m][1]}};
                    if (ropew) {
                        const double pos = (double)(row < EW_MP ? row : 4096 + ((row - EW_MP) & 31));
#pragma unroll
                        for (int n = 0; n < 2; ++n)
#pragma unroll
                            for (int i = 0; i < 4; ++i) { const double rev = pos * rc[n * 4 + i]; const float f = (float)(rev - __builtin_rint(rev));
                                const float sn = __builtin_amdgcn_sinf(f), cs = __builtin_amdgcn_cosf(f);
#pragma unroll
                                for (int bj = 0; bj < 2; ++bj) { const float x = v[bj][n][i], p = __shfl_xor(x, 16);
                                    const float r = (fq == 0) ? x * cs - p * sn : x * cs + p * sn; v[bj][n][i] = (fq < 2) ? r : x; } }
                    }
#pragma unroll
                    for (int bj = 0; bj < 2; ++bj) { const int cq = (pn & 1) * BM + bj * HALF + cl;
                        const float qs = is_k ? 1.0f : 0.18033688011112042f;
                        *(u32x4*)((is_k ? K : Q) + (size_t)row * 512 + cq) = pack8(v[bj][0] * qs, v[bj][1] * qs);
                        if (is_k) { float* o = out + (row < EW_MP ? EW_OFF_KP + (size_t)row * 512 : EW_OFF_KS + (size_t)(row - EW_MP) * 512) + cq; *(f32x4*)o = v[bj][0]; *(f32x4*)(o + 4) = v[bj][1]; } } }
        } else if (pn < 8) {
#pragma unroll
            for (int ai = 0; ai < 2; ++ai)
#pragma unroll
                for (int m = 0; m < 4; ++m) { const int row = row0 + ai * HALF + m * 16;
                    const int k16 = row & 15, tp = (row & ~15) | ((k16 & 3) + ((k16 >> 3) & 1) * 4 + ((k16 >> 2) & 1) * 8);
#pragma unroll
                    for (int bj = 0; bj < 2; ++bj) { const int cv = (pn & 1) * BM + bj * HALF + cl;
                        float* o = out + (row < EW_MP ? EW_OFF_VP + (size_t)row * 512 : EW_OFF_VS + (size_t)(row - EW_MP) * 512) + cv; *(f32x4*)o = acc[ai][bj][m][0]; *(f32x4*)(o + 4) = acc[ai][bj][m][1];
                        if (row < EW_MP) { const u32x4 w = pack8(acc[ai][bj][m][0], acc[ai][bj][m][1]); bf16_t* vp = VT + (size_t)cv * EW_MP + tp;
                            vp[0] = (bf16_t)w.x; vp[EW_MP] = (bf16_t)(w.x >> 16); vp[2 * EW_MP] = (bf16_t)w.y; vp[3 * EW_MP] = (bf16_t)(w.y >> 16);
                            vp[4 * EW_MP] = (bf16_t)w.z; vp[5 * EW_MP] = (bf16_t)(w.z >> 16); vp[6 * EW_MP] = (bf16_t)w.w; vp[7 * EW_MP] = (bf16_t)(w.w >> 16); } } }
        } else {
#pragma unroll
            for (int ai = 0; ai < 2; ++ai)
#pragma unroll
                for (int m = 0; m < 4; ++m) { const int row = row0 + ai * HALF + m * 16;
#pragma unroll
                    for (int bj = 0; bj < 2; ++bj) { const int c0 = (pn - 8) * BM + bj * HALF + cl; f32x4 a = acc[ai][bj][m][0], b = acc[ai][bj][m][1];
#pragma unroll
                        for (int i = 0; i < 4; ++i) { a[i] = sigm(a[i]); b[i] = sigm(b[i]); }
                        *(u32x4*)(GATES + (size_t)row * 2048 + c0) = pack8(a, b); } }
        }
    }
};
template <class Epi, class Sched, bool ALIGN_EPI = false, bool SP2 = false>
__device__ __forceinline__ void gemm_phase(PG8_LAS unsigned char* lds, const Gemm g, const Sched& S, const Epi& E) {
    const int tid = threadIdx.x, wid = __builtin_amdgcn_readfirstlane(tid >> 6), lane = tid & 63, wr = wid >> 2, wc = wid & 3, fr = lane & 15, fq = lane >> 4;
    const int K = g.K; int nt;
    unsigned voffA[2], voffB[2];
#pragma unroll
    for (int i = 0; i < 2; ++i) { int R, C; stage_rc(tid * 16 + i * 8192, R, C); const int Rb = Epi::PERM ? ((R & ~31) + perm32(R & 31)) : R;
        voffA[i] = (unsigned)(R * K + C) * 2u; voffB[i] = (unsigned)(Rb * K + C) * 2u; }
    const size_t kstep = (size_t)(BK * 2);
    const size_t hstep = (size_t)HALF * K * 2;
    const size_t tstep = 2 * hstep;
    const unsigned ldsw = (unsigned)wid * 1024u;
    const int aoff = lds_byte(wr * 64 + fr, fq * 8), boff = lds_byte(wc * 32 + fr, fq * 8);
#define PG8_SA(b, h) (((b) * 2 + (h)) * HTB)
#define PG8_SB(b, h) ((4 + (b) * 2 + (h)) * HTB)
#define PG8_STAGE(bufoff, gbase, voff) do { _Pragma("unroll") for (int _i = 0; _i < 2; ++_i) \
        __builtin_amdgcn_global_load_lds((const unsigned*)((const char*)(gbase) + (voff)[_i]), (PG8_LAS unsigned*)(lds + (bufoff) + ldsw + _i * 8192), 16, 0, 0); } while (0)
#define PG8_LDA(dst, b, h) do { _Pragma("unroll") for (int m = 0; m < 4; ++m) _Pragma("unroll") for (int k = 0; k < 2; ++k) dst[m][k] = *(const PG8_LAS bf16x8*)(lds + PG8_SA(b, h) + aoff + m * 2048 + k * 1024); } while (0)
#define PG8_LDB(dst, b, h) do { _Pragma("unroll") for (int n = 0; n < 2; ++n) _Pragma("unroll") for (int k = 0; k < 2; ++k) dst[n][k] = *(const PG8_LAS bf16x8*)(lds + PG8_SB(b, h) + boff + n * 2048 + k * 1024); } while (0)
#define PG8_MMA(ai, bj, At, Bt) do { __builtin_amdgcn_s_setprio(1); _Pragma("unroll") for (int m = 0; m < 4; ++m) _Pragma("unroll") for (int n = 0; n < 2; ++n) _Pragma("unroll") for (int k = 0; k < 2; ++k) \
        acc[ai][bj][m][n] = __builtin_amdgcn_mfma_f32_16x16x32_bf16(Bt[n][k], At[m][k], acc[ai][bj][m][n], 0, 0, 0); __builtin_amdgcn_s_setprio(0); } while (0)
#define PG8_WAIT_V(n) asm volatile("s_waitcnt vmcnt(" #n ")" ::: "memory")
#define PG8_WAIT_L(n) asm volatile("s_waitcnt lgkmcnt(" #n ")" ::: "memory")
#define PG8_BAR __builtin_amdgcn_s_barrier()
#define PG8_SCHED __builtin_amdgcn_sched_barrier(0)
    Unit cur, nxt; int ui = 0;
    if (!S.next(0, cur)) return;
    f32x4 acc[2][2][4][2];
#pragma unroll
    for (int a = 0; a < 2; ++a)
#pragma unroll
        for (int b = 0; b < 2; ++b)
#pragma unroll
            for (int m = 0; m < 4; ++m)
#pragma unroll
                for (int n = 0; n < 2; ++n) acc[a][b][m][n] = (f32x4){0.f, 0.f, 0.f, 0.f};
    bf16x8 At[4][2], B0[2][2], B1[2][2];
    const char* cA = (const char*)g.A + (size_t)cur.pm * tstep + (size_t)S.kt0(cur) * kstep; const char* cB = (const char*)g.Bt + (size_t)cur.pn * tstep + (size_t)S.kt0(cur) * kstep; nt = S.nt(cur);
    S.a_ready(cur);
    if constexpr (SP2) {
        PG8_STAGE(PG8_SB(0, 0), cB, voffB); PG8_STAGE(PG8_SB(0, 1), cB + hstep, voffB); PG8_STAGE(PG8_SA(0, 0), cA, voffA); PG8_STAGE(PG8_SA(0, 1), cA + hstep, voffA);
        if (wr == 1) PG8_BAR;
        PG8_WAIT_V(2); PG8_BAR;
        PG8_STAGE(PG8_SB(1, 0), cB + kstep, voffB); PG8_STAGE(PG8_SA(1, 0), cA + kstep, voffA); PG8_STAGE(PG8_SB(1, 1), cB + hstep + kstep, voffB);
        PG8_WAIT_V(6); PG8_BAR;
    } else {
        PG8_STAGE(PG8_SB(0, 0), cB, voffB); PG8_STAGE(PG8_SA(0, 0), cA, voffA); PG8_STAGE(PG8_SB(0, 1), cB + hstep, voffB); PG8_STAGE(PG8_SA(0, 1), cA + hstep, voffA);
        if (wr == 1) PG8_BAR;
        PG8_WAIT_V(4); PG8_BAR;
        PG8_STAGE(PG8_SB(1, 0), cB + kstep, voffB); PG8_STAGE(PG8_SA(1, 0), cA + kstep, voffA); PG8_STAGE(PG8_SB(1, 1), cB + hstep + kstep, voffB);
        PG8_WAIT_V(6); PG8_BAR;
    }
    for (;;) {
        const bool has_next = S.next(ui + 1, nxt);
        const char* nA = has_next ? (const char*)g.A + (size_t)nxt.pm * tstep + (size_t)S.kt0(nxt) * kstep : cA; const char* nB = has_next ? (const char*)g.Bt + (size_t)nxt.pn * tstep + (size_t)S.kt0(nxt) * kstep : cB;
        for (int t = 0; t < nt; t += 2) {
            const bool last = (t == nt - 2);
            const char* a1 = cA + (size_t)(t + 1) * kstep;
            const char* a2 = last ? nA : cA + (size_t)(t + 2) * kstep; const char* b2 = last ? nB : cB + (size_t)(t + 2) * kstep;
            const char* a3 = a2 + kstep; const char* b3 = b2 + kstep;
            if (last && has_next) S.a_ready(nxt);
            if constexpr (SP2) {
            PG8_LDB(B0, 0, 0); PG8_LDB(B1, 0, 1); PG8_SCHED; PG8_LDA(At, 0, 0); PG8_STAGE(PG8_SA(1, 1), a1 + hstep, voffA);
            PG8_WAIT_V(8); PG8_WAIT_L(0); PG8_BAR; PG8_MMA(0, 0, At, B0); PG8_MMA(0, 1, At, B1); PG8_BAR; PG8_SCHED;
            PG8_LDA(At, 0, 1); PG8_STAGE(PG8_SB(0, 0), b2, voffB); PG8_STAGE(PG8_SB(0, 1), b2 + hstep, voffB); PG8_STAGE(PG8_SA(0, 0), a2, voffA);
            PG8_WAIT_V(8); PG8_WAIT_L(0); PG8_BAR; PG8_MMA(1, 0, At, B0); PG8_MMA(1, 1, At, B1); PG8_BAR; PG8_SCHED;
            PG8_LDB(B0, 1, 0); PG8_LDB(B1, 1, 1); PG8_SCHED; PG8_LDA(At, 1, 0); PG8_STAGE(PG8_SA(0, 1), a2 + hstep, voffA);
            PG8_WAIT_V(8); PG8_WAIT_L(0); PG8_BAR; PG8_MMA(0, 0, At, B0); PG8_MMA(0, 1, At, B1); PG8_BAR; PG8_SCHED;
            PG8_LDA(At, 1, 1); PG8_STAGE(PG8_SB(1, 0), b3, voffB); PG8_STAGE(PG8_SB(1, 1), b3 + hstep, voffB); PG8_STAGE(PG8_SA(1, 0), a3, voffA);
            PG8_WAIT_V(8); PG8_WAIT_L(0); PG8_BAR; PG8_MMA(1, 0, At, B0); PG8_MMA(1, 1, At, B1); PG8_BAR; PG8_SCHED;
            } else {
            PG8_LDB(B0, 0, 0); PG8_SCHED; PG8_LDA(At, 0, 0); PG8_STAGE(PG8_SA(1, 1), a1 + hstep, voffA);
            PG8_WAIT_L(8); PG8_BAR; PG8_WAIT_L(0); PG8_MMA(0, 0, At, B0); PG8_BAR; PG8_SCHED;
            PG8_LDB(B1, 0, 1); PG8_STAGE(PG8_SB(0, 0), b2, voffB);
            PG8_BAR; PG8_WAIT_L(0); PG8_MMA(0, 1, At, B1); PG8_BAR;
            PG8_LDA(At, 0, 1); PG8_STAGE(PG8_SA(0, 0), a2, voffA);
            PG8_BAR; PG8_WAIT_L(0); PG8_MMA(1, 0, At, B0); PG8_BAR; PG8_SCHED;
            PG8_STAGE(PG8_SB(0, 1), b2 + hstep, voffB);
            PG8_WAIT_V(6); PG8_BAR; PG8_MMA(1, 1, At, B1); PG8_BAR;
            PG8_LDB(B0, 1, 0); PG8_SCHED; PG8_LDA(At, 1, 0); PG8_STAGE(PG8_SA(0, 1), a2 + hstep, voffA);
            PG8_WAIT_L(8); PG8_BAR; PG8_WAIT_L(0); PG8_MMA(0, 0, At, B0); PG8_BAR; PG8_SCHED;
            PG8_LDB(B1, 1, 1); PG8_STAGE(PG8_SB(1, 0), b3, voffB);
            PG8_BAR; PG8_WAIT_L(0); PG8_MMA(0, 1, At, B1); PG8_BAR;
            PG8_LDA(At, 1, 1); PG8_STAGE(PG8_SA(1, 0), a3, voffA);
            PG8_BAR; PG8_WAIT_L(0); PG8_MMA(1, 0, At, B0); PG8_BAR; PG8_SCHED;
            PG8_STAGE(PG8_SB(1, 1), b3 + hstep, voffB);
            PG8_WAIT_V(6); PG8_BAR; PG8_MMA(1, 1, At, B1); PG8_BAR;
            }
        }
        if constexpr (ALIGN_EPI) { if (wr == 0) PG8_BAR; }
        if constexpr (!Epi::AFTER_DRAIN) { E(acc, cur, wr, wc, fr, fq); S.done(cur); }
        if (!has_next) break;
#pragma unroll
        for (int a = 0; a < 2; ++a)
#pragma unroll
            for (int b = 0; b < 2; ++b)
#pragma unroll
                for (int m = 0; m < 4; ++m)
#pragma unroll
                    for (int n = 0; n < 2; ++n) acc[a][b][m][n] = (f32x4){0.f, 0.f, 0.f, 0.f};
        cur = nxt; cA = nA; cB = nB; nt = S.nt(cur); ++ui;
        if constexpr (ALIGN_EPI) { if (wr == 1) PG8_BAR; }
    }
    PG8_WAIT_V(0);
    if constexpr (!ALIGN_EPI) { if (wr == 0) PG8_BAR; }
    PG8_BAR;
    if constexpr (Epi::AFTER_DRAIN) { E.fused(acc, cur, wr, wc, fr, fq, lds, wid, lane); S.done(cur); }
#undef PG8_SA
#undef PG8_SB
#undef PG8_STAGE
#undef PG8_LDA
#undef PG8_LDB
#undef PG8_MMA
#undef PG8_WAIT_V
#undef PG8_WAIT_L
#undef PG8_BAR
#undef PG8_SCHED
}
}
#define LAS __attribute__((address_space(3)))
typedef unsigned short bf16;
typedef short bf16x8 __attribute__((ext_vector_type(8)));
typedef float f32x4 __attribute__((ext_vector_type(4)));
typedef float f32x16 __attribute__((ext_vector_type(16)));
typedef unsigned u32x4 __attribute__((ext_vector_type(4)));
typedef unsigned u32x2 __attribute__((ext_vector_type(2)));

constexpr int DMODEL = 1024, MP = 16384, MS = 512, M = MP + MS, DFF = 2816, NGU = 2 * DFF, PASTL = 4096;
constexpr float EPS = 1e-6f, LAM_INIT = 0.2f;
constexpr size_t OFF_KP = 17301504, OFF_VP = 25690112, OFF_PP = 34078720, OFF_KS = 34086400, OFF_VS = 34348544, OFF_PS = 34610688, OUT_TOTAL = 34733568;
constexpr size_t MiB = 1u << 20;
constexpr size_t WS_WGU1 = 2 * MiB, WS_WD1 = 13 * MiB, WS_WIN = 19 * MiB, WS_WC = 27 * MiB, WS_WBA = 28 * MiB, WS_WOUT = 29 * MiB, WS_WGU2 = 31 * MiB, WS_WD2 = 42 * MiB;
constexpr size_t WS_XN = 48 * MiB, WS_HID = 81 * MiB, WS_D = 172 * MiB, WS_H = 238 * MiB, WS_UPOOL = 304 * MiB, WS_Q = 321 * MiB, WS_K = 338 * MiB, WS_VT = 355 * MiB;
constexpr size_t WS_GATES = 371 * MiB, WS_MIXED = 437 * MiB, WS_ATTN = 454 * MiB, WS_SPART = 471 * MiB, WS_DP = 480 * MiB, WS_END = 502 * MiB;
constexpr int SPART_FLOATS = 64 * 64 + 128;
constexpr int LDS_BYTES = 155712;
constexpr int NPH = 14;
#ifndef POOL_REP
#define POOL_REP 1
#endif
#ifndef SAMP_REP
#define SAMP_REP 1
#endif
#ifndef SYNC_REP
#define SYNC_REP 0
#endif
#ifndef ATT_REP
#define ATT_REP 1
#endif
#ifndef REP_MASK
#define REP_MASK 0
#endif

__device__ __forceinline__ float wave_sum(float v) {
#pragma unroll
    for (int o = 1; o < 64; o <<= 1) v += __shfl_xor(v, o);
    return v;
}
__device__ __forceinline__ unsigned pk2(float lo, float hi) { return pg8::cvt_pk_bf16(lo, hi); }
__device__ __forceinline__ bf16x8 pack_bf8(float a0, float a1, float a2, float a3, float a4, float a5, float a6, float a7) {
    u32x4 w; w.x = pk2(a0, a1); w.y = pk2(a2, a3); w.z = pk2(a4, a5); w.w = pk2(a6, a7); return __builtin_bit_cast(bf16x8, w);
}
typedef float f32x2_t __attribute__((ext_vector_type(2))); typedef __bf16 bf16x2_t __attribute__((ext_vector_type(2)));
__device__ __forceinline__ unsigned pk2v(float lo, float hi) { f32x2_t v = {lo, hi}; bf16x2_t b = __builtin_convertvector(v, bf16x2_t); return __builtin_bit_cast(unsigned, b); }
__device__ __forceinline__ bf16x8 pack_bf8v(float a0, float a1, float a2, float a3, float a4, float a5, float a6, float a7) {
    u32x4 w; w.x = pk2v(a0, a1); w.y = pk2v(a2, a3); w.z = pk2v(a4, a5); w.w = pk2v(a6, a7); return __builtin_bit_cast(bf16x8, w);
}
__device__ __forceinline__ f32x16 mfma32(bf16x8 a, bf16x8 b, f32x16 c) { return __builtin_amdgcn_mfma_f32_32x32x16_bf16(a, b, c, 0, 0, 0); }

__device__ __forceinline__ void transpose_item(const float* W, int ldw, int K, bf16* WT, int dst_row0, int src_n0, int k0, LAS float* scr, int lane) {
#pragma unroll 4
    for (int i = 0; i < 16; ++i) { const int kk = 4 * i + (lane >> 4), nn = 4 * (lane & 15); const f32x4 v = *(const f32x4*)(W + (size_t)(k0 + kk) * ldw + src_n0 + nn);
        LAS float* d = scr + kk * 65 + nn; d[0] = v[0]; d[1] = v[1]; d[2] = v[2]; d[3] = v[3]; }
    asm volatile("s_waitcnt lgkmcnt(0)" ::: "memory");
#pragma unroll
    for (int j = 0; j < 8; ++j) { const int q = lane + 64 * j, n = q >> 3, c = q & 7; const LAS float* t = scr + (8 * c) * 65 + n;
        u32x4 o; o.x = pk2(t[0 * 65], t[1 * 65]); o.y = pk2(t[2 * 65], t[3 * 65]); o.z = pk2(t[4 * 65], t[5 * 65]); o.w = pk2(t[6 * 65], t[7 * 65]);
        *(u32x4*)(WT + (size_t)(dst_row0 + n) * K + k0 + 8 * c) = o; }
    asm volatile("s_waitcnt lgkmcnt(0)" ::: "memory");
}
__device__ __forceinline__ void transpose_mat(const float* W, int K, int N, bf16* WT, bool gu, int gw, int NGW, LAS float* scr, int lane) {
    const int nblk = N / 64, nitems = (K / 64) * nblk;
    for (int it = gw; it < nitems; it += NGW) { const int kb = it / nblk, nb = it % nblk; const int src = 64 * nb; int dst = src;
        if (gu) { const int up = src >= DFF ? 1 : 0, sl = src - up * DFF; dst = (sl / 128) * 256 + up * 128 + (sl % 128); }
        transpose_item(W, N, K, WT, dst, src, 64 * kb, scr, lane); }
}
__device__ __forceinline__ const float* xrow_ptr(const float* xp, const float* xs, int row) { return row < MP ? xp + (size_t)row * DMODEL : xs + (size_t)(row - MP) * DMODEL; }
__device__ __forceinline__ void norm_row_bf16(const f32x4 (&v)[4], const float* g, bf16* orow, int lane) {
    float s = 0.f;
#pragma unroll
    for (int j = 0; j < 4; ++j) s += (v[j][0] * v[j][0] + v[j][1] * v[j][1]) + (v[j][2] * v[j][2] + v[j][3] * v[j][3]);
    const float r = 1.0f / sqrtf(wave_sum(s) * (1.f / DMODEL) + EPS);
#pragma unroll
    for (int j = 0; j < 4; ++j) { const f32x4 gg = *((const f32x4*)g + lane + 64 * j); u32x2 w; w.x = pk2(v[j][0] * r * gg[0], v[j][1] * r * gg[1]); w.y = pk2(v[j][2] * r * gg[2], v[j][3] * r * gg[3]);
        *((u32x2*)orow + lane + 64 * j) = w; }
}
__device__ __forceinline__ void resnorm_rows(const float* xp, const float* xs, const float* Hbase, const float* D, const float* DP, int nslab, float rs, const float* gpost, float* outf, const float* gnext, bf16* XN, int gw, int NGW, int lane) {
    for (int row = gw; row < M; row += NGW) {
        const float* b = Hbase ? Hbase + (size_t)row * DMODEL : xrow_ptr(xp, xs, row);
        f32x4 d[4], h[4]; float s = 0.f;
#pragma unroll
        for (int j = 0; j < 4; ++j) { h[j] = *((const f32x4*)b + lane + 64 * j);
            if (row < MP) d[j] = *((const f32x4*)(D + (size_t)row * DMODEL) + lane + 64 * j);
            else { d[j] = *((const f32x4*)(DP + (size_t)(row - MP) * DMODEL) + lane + 64 * j); for (int sl = 1; sl < nslab; ++sl) d[j] += *((const f32x4*)(DP + ((size_t)sl * 512 + row - MP) * DMODEL) + lane + 64 * j); }
            s += (d[j][0] * d[j][0] + d[j][1] * d[j][1]) + (d[j][2] * d[j][2] + d[j][3] * d[j][3]); }
        const float r = rs / sqrtf(wave_sum(s) * (1.f / DMODEL) + EPS);
#pragma unroll
        for (int j = 0; j < 4; ++j) { const f32x4 gg = *((const f32x4*)gpost + lane + 64 * j); h[j] = h[j] + d[j] * gg * r; *((f32x4*)(outf + (size_t)row * DMODEL) + lane + 64 * j) = h[j]; }
        if (gnext) norm_row_bf16(h, gnext, XN + (size_t)row * DMODEL, lane);
    }
}
__device__ __forceinline__ float compute_lam(const float* q1, const float* k1, const float* q2, const float* k2, int lane) {
    const float a = wave_sum(q1[lane] * k1[lane]), b = wave_sum(q2[lane] * k2[lane]);
    const float l = expf(a) - expf(b) + LAM_INIT;
    return __builtin_bit_cast(float, __builtin_amdgcn_readfirstlane(__builtin_bit_cast(int, l)));
}

namespace att {
constexpr int KSTR = 272, VSTR = 144, KBUF = 64 * KSTR, VBUF = 128 * VSTR, STAGE = KBUF + VBUF;
constexpr float C2 = 0.125f * 1.4426950408889634f, THR = 8.0f;
__device__ __forceinline__ int crow(int r, int hi) { return (r & 3) + 8 * (r >> 2) + 4 * hi; }
__device__ __forceinline__ float max3f(float a, float b, float c) { return __builtin_fmaxf(__builtin_fmaxf(a, b), c); }
__device__ __forceinline__ float max16(const f32x16& p) { float m = max3f(p[0], p[1], p[2]); m = max3f(m, p[3], p[4]); m = max3f(m, p[5], p[6]); m = max3f(m, p[7], p[8]);
    m = max3f(m, p[9], p[10]); m = max3f(m, p[11], p[12]); m = max3f(m, p[13], p[14]); return __builtin_fmaxf(m, p[15]); }

__device__ __forceinline__ void finish_store(f32x16 (&o)[4], const float* sg, bf16* orow, int hi) {
    float ss = 0.f;
#pragma unroll
    for (int cb = 0; cb < 4; ++cb)
#pragma unroll
        for (int r = 0; r < 16; ++r) ss += o[cb][r] * o[cb][r];
    ss += __shfl_xor(ss, 32);
    const float rn = (1.0f - LAM_INIT) / sqrtf(ss * (1.f / 128.f) + EPS);
#pragma unroll
    for (int cb = 0; cb < 4; ++cb)
#pragma unroll
        for (int r4 = 0; r4 < 4; ++r4) { const int col = cb * 32 + 8 * r4 + 4 * hi; const f32x4 g = *(const f32x4*)(sg + col);
            u32x2 w; w.x = pk2(o[cb][4 * r4] * rn * g[0], o[cb][4 * r4 + 1] * rn * g[1]); w.y = pk2(o[cb][4 * r4 + 2] * rn * g[2], o[cb][4 * r4 + 3] * rn * g[3]);
            *(u32x2*)(orow + col) = w; }
}

constexpr int DSTG = 32768;
__device__ __forceinline__ void prompt_unit(int h, int qb, const bf16* Q, const bf16* K, const bf16* VT, bf16* ATTN, float lam, const float* sg, LAS char* lds) {
    int tid = threadIdx.x; asm volatile("" : "+v"(tid));
    const int lane = tid & 63, r32 = lane & 31, hi = lane >> 5, wid = __builtin_amdgcn_readfirstlane(tid >> 6), rg = wid & 3, c = wid >> 2;
    const int qrow = 128 * qb + 32 * rg + r32;
    bf16x8 qf0;
    LAS char* qlds = lds + 4 * DSTG + wid * 3072 + lane * 16;
    qf0 = *(const bf16x8*)(Q + (size_t)qrow * 512 + h * 128 + c * 64 + 8 * hi);
#pragma unroll
    for (int d0 = 1; d0 < 4; ++d0) *(LAS bf16x8*)(qlds + (d0 - 1) * 1024) = *(const bf16x8*)(Q + (size_t)qrow * 512 + h * 128 + c * 64 + 16 * d0 + 8 * hi);
#define QFR(d0) ((d0) == 0 ? qf0 : *(const LAS bf16x8*)(qlds + ((d0) - 1) * 1024))
    const int ntiles = 2 * qb + 2, myn = 2 * qb + 1 + (rg >> 1);
    unsigned ksrc0, vsrc0;
    { const int row = 4 * rg + (lane >> 4), ch = (lane & 15) ^ (row & 15); ksrc0 = (unsigned)(row * 512 + h * 128) * 2u + (unsigned)ch * 16u; }
    { const int row = 8 * rg + (lane >> 3), ch = (lane & 7) ^ ((row >> 1) & 7); vsrc0 = (unsigned)((h * 128 + row) * MP) * 2u + (unsigned)ch * 16u; }
    const char* Kc = (const char*)K; const char* Vc = (const char*)VT;
#define ATT_DMA(jt, stg) do { const int jj_ = (jt) < ntiles ? (jt) : ntiles - 1; const char* kt_ = Kc + (size_t)jj_ * (64 * 512 * 2); const char* vt_ = Vc + (size_t)jj_ * 128; \
        _Pragma("unroll") for (int i_ = 0; i_ < 4; ++i_) { \
            __builtin_amdgcn_global_load_lds((const unsigned*)(kt_ + (size_t)i_ * (16 * 512 * 2) + ksrc0), (LAS unsigned*)(lds + (stg) + (rg + 4 * i_) * 1024), 16, 0, 0); \
            __builtin_amdgcn_global_load_lds((const unsigned*)(vt_ + (size_t)i_ * (32 * (size_t)MP * 2) + vsrc0), (LAS unsigned*)(lds + (stg) + 16384 + (rg + 4 * i_) * 1024), 16, 0, 0); } } while (0)
#define WAITV0() asm volatile("s_waitcnt vmcnt(0)" ::: "memory")
#define BAR() do { asm volatile("s_waitcnt lgkmcnt(0)" ::: "memory"); __builtin_amdgcn_s_barrier(); asm volatile("" ::: "memory"); } while (0)
    const int Ak = r32 * 256 + ((c * 8 + hi) ^ (r32 & 15)) * 16, Bv = 16384 + r32 * 128 + (hi ^ ((r32 >> 1) & 7)) * 16;
#define KLD(stg, half, d0) (*(const LAS bf16x8*)(lds + (stg) + (half) * 8192 + (ak_ ^ ((d0) << 5))))
#define VLD(stg, cb, ks) (*(const LAS bf16x8*)(lds + (stg) + (cb) * 4096 + (bv_ ^ ((ks) << 5))))
#define ATT_QK(P0, P1, stg) do { int ak_ = Ak; asm volatile("" : "+v"(ak_)); P0 = f32x16{}; P1 = f32x16{}; \
        _Pragma("unroll") for (int d0 = 0; d0 < 4; ++d0) { const bf16x8 ka = KLD(stg, 0, d0), kc = KLD(stg, 1, d0); P0 = mfma32(ka, QFR(d0), P0); P1 = mfma32(kc, QFR(d0), P1); } } while (0)
#define EX2(P, r) do { P[r] = __builtin_amdgcn_exp2f(P[r] - mref); ls += P[r]; } while (0)
#define SBX() __builtin_amdgcn_sched_barrier(0)
#define S_BLOCK(k, P0, P1) do { \
        float mx = fmaxf(max16(P0), max16(P1)); \
        { const unsigned mu_ = __float_as_uint(mx); auto rr_ = __builtin_amdgcn_permlane32_swap(mu_, mu_, false, false); mx = fmaxf(__uint_as_float(rr_[0]), __uint_as_float(rr_[1])); } \
        if (__any(mx > mref + THR)) { const float nr = fmaxf(mref, mx), al = __builtin_amdgcn_exp2f(mref - nr); mref = nr; lsum *= al; \
            _Pragma("unroll") for (int cb = 0; cb < 4; ++cb) _Pragma("unroll") for (int r = 0; r < 16; ++r) o[cb][r] *= al; } \
        float ls = 0.f; \
        _Pragma("unroll") for (int r = 0; r < 16; ++r) EX2(P0, r); \
        pf0 = pack_bf8v(P0[0], P0[1], P0[2], P0[3], P0[4], P0[5], P0[6], P0[7]); pf1 = pack_bf8v(P0[8], P0[9], P0[10], P0[11], P0[12], P0[13], P0[14], P0[15]); \
        _Pragma("unroll") for (int r = 0; r < 16; ++r) EX2(P1, r); \
        pf2 = pack_bf8v(P1[0], P1[1], P1[2], P1[3], P1[4], P1[5], P1[6], P1[7]); pf3 = pack_bf8v(P1[8], P1[9], P1[10], P1[11], P1[12], P1[13], P1[14], P1[15]); \
        lsum += ls; \
        } while (0)
#define M_BLOCK(k, P0, P1) do { const int sv_ = ((k) & 3) * DSTG, sk_ = (((k) + 2) & 3) * DSTG; bf16x8 va[4], vb[4]; int ak_ = Ak, bv_ = Bv; asm volatile("" : "+v"(ak_), "+v"(bv_));     \
        _Pragma("unroll") for (int cb = 0; cb < 4; ++cb) { va[cb] = VLD(sv_, cb, 0); vb[cb] = VLD(sv_, cb, 1); } \
        SBX(); \
        _Pragma("unroll") for (int cb = 0; cb < 4; ++cb) { o[cb] = mfma32(va[cb], pf0, o[cb]); va[cb] = VLD(sv_, cb, 2); } \
        SBX(); \
        _Pragma("unroll") for (int cb = 0; cb < 4; ++cb) { o[cb] = mfma32(vb[cb], pf1, o[cb]); vb[cb] = VLD(sv_, cb, 3); } \
        SBX(); \
        _Pragma("unroll") for (int cb = 0; cb < 4; ++cb) { o[cb] = mfma32(va[cb], pf2, o[cb]); va[cb] = KLD(sk_, cb & 1, cb >> 1); } \
        SBX(); \
        _Pragma("unroll") for (int cb = 0; cb < 4; ++cb) { o[cb] = mfma32(vb[cb], pf3, o[cb]); vb[cb] = KLD(sk_, cb & 1, 2 + (cb >> 1)); } \
        SBX(); \
        P0 = f32x16{}; P1 = f32x16{}; \
        { const bf16x8 q1_ = QFR(1), q2_ = QFR(2), q3_ = QFR(3); \
        P0 = mfma32(va[0], qf0, P0); P1 = mfma32(va[1], qf0, P1); P0 = mfma32(va[2], q1_, P0); P1 = mfma32(va[3], q1_, P1); \
        P0 = mfma32(vb[0], q2_, P0); P1 = mfma32(vb[1], q2_, P1); P0 = mfma32(vb[2], q3_, P0); P1 = mfma32(vb[3], q3_, P1); } \
        SBX(); } while (0)
    f32x16 o[4];
#pragma unroll
    for (int cb = 0; cb < 4; ++cb) o[cb] = f32x16{};
    float mref = -INFINITY, lsum = 0.f;
    f32x16 e0, e1, d0s, d1s;
    bf16x8 pf0, pf1, pf2, pf3;
    if (c == 0) { ATT_DMA(0, 0); ATT_DMA(1, DSTG); ATT_DMA(2, 2 * DSTG); }
    if (c == 1) __builtin_amdgcn_s_setprio(1);
    WAITV0(); BAR();
    ATT_QK(e0, e1, 0); ATT_QK(d0s, d1s, DSTG);
    if (c == 0) {
        for (int k = 0; k < ntiles; k += 2) {
            if (k < myn) S_BLOCK(k, e0, e1);
            WAITV0(); BAR();
            ATT_DMA(k + 3, ((k + 3) & 3) * DSTG);
            if (k < myn) M_BLOCK(k, e0, e1);
            BAR();
            if (k + 1 < myn) S_BLOCK(k + 1, d0s, d1s);
            WAITV0(); BAR();
            ATT_DMA(k + 4, ((k + 4) & 3) * DSTG);
            if (k + 1 < myn) M_BLOCK(k + 1, d0s, d1s);
            BAR();
        }
        WAITV0(); BAR();
    } else {
        BAR();
        for (int k = 0; k < ntiles; k += 2) {
            if (k < myn) S_BLOCK(k, e0, e1);
            BAR();
            if (k < myn) M_BLOCK(k, e0, e1);
            BAR();
            if (k + 1 < myn) S_BLOCK(k + 1, d0s, d1s);
            BAR();
            if (k + 1 < myn) M_BLOCK(k + 1, d0s, d1s);
            BAR();
        }
    }
#undef QFR
#undef ATT_DMA
#undef WAITV0
#undef BAR
#undef KLD
#undef VLD
#undef ATT_QK
#undef EX2
#undef S_BLOCK
#undef SBX
#undef M_BLOCK
    __builtin_amdgcn_s_setprio(0);
    lsum += __shfl_xor(lsum, 32);
    const float inv = 1.0f / lsum;
    int t2 = threadIdx.x; asm volatile("" : "+v"(t2));
    float lamv = __builtin_bit_cast(float, __builtin_amdgcn_readfirstlane(__builtin_bit_cast(int, lam))); asm volatile("" : "+s"(lamv));
    const int lane2 = t2 & 63, hi2 = lane2 >> 5, qrow2 = 128 * qb + 32 * rg + (lane2 & 31);
    LAS float* xb = (LAS float*)lds + (size_t)rg * 4096 + lane2;
    __syncthreads();
    if (c == 1) {
#pragma unroll
        for (int cb = 0; cb < 4; ++cb)
#pragma unroll
            for (int r = 0; r < 16; ++r) xb[(cb * 16 + r) * 64] = o[cb][r] * inv;
    }
    __syncthreads();
    if (c == 0) {
#pragma unroll
        for (int cb = 0; cb < 4; ++cb)
#pragma unroll
            for (int r = 0; r < 16; ++r) o[cb][r] = o[cb][r] * inv - lamv * xb[(cb * 16 + r) * 64];
        finish_store(o, sg, ATTN + (size_t)qrow2 * 512 + h * 128, hi2);
    }
    __syncthreads();
}

__device__ __forceinline__ void sample_block(const float* Kp, const float* Vp, const bf16x8 (&qf)[2][4], f32x16 (&o)[2][4], float (&mref)[2], float (&lsum)[2], int r32, int hi) {
    bf16x8 pf[2][2];
#pragma unroll
    for (int c = 0; c < 2; ++c) {
        f32x16 p = f32x16{};
#pragma unroll
        for (int d0 = 0; d0 < 4; ++d0) { const float* kp = Kp + (size_t)r32 * 512 + c * 64 + 16 * d0 + 8 * hi; const f32x4 a = *(const f32x4*)kp, b = *(const f32x4*)(kp + 4);
            p = mfma32(pack_bf8(a[0], a[1], a[2], a[3], b[0], b[1], b[2], b[3]), qf[c][d0], p); }
        float mx = max16(p); mx = fmaxf(mx, __shfl_xor(mx, 32));
        const float ms = mx;
        if (__any(ms > mref[c] + THR)) { const float nr = fmaxf(mref[c], ms), al = __builtin_amdgcn_exp2f(mref[c] - nr); mref[c] = nr; lsum[c] *= al;
#pragma unroll
            for (int cb = 0; cb < 4; ++cb)
#pragma unroll
                for (int r = 0; r < 16; ++r) o[c][cb][r] *= al; }
        float ls = 0.f;
#pragma unroll
        for (int r = 0; r < 16; ++r) { p[r] = __builtin_amdgcn_exp2f(p[r] - mref[c]); ls += p[r]; }
        lsum[c] += ls;
        pf[c][0] = pack_bf8(p[0], p[1], p[2], p[3], p[4], p[5], p[6], p[7]); pf[c][1] = pack_bf8(p[8], p[9], p[10], p[11], p[12], p[13], p[14], p[15]);
    }
#pragma unroll
    for (int cb = 0; cb < 4; ++cb)
#pragma unroll
        for (int ks = 0; ks < 2; ++ks) { const float* vp = Vp + (size_t)(16 * ks + 4 * hi) * 512 + cb * 32 + r32;
            const bf16x8 vf = pack_bf8(vp[0], vp[512], vp[1024], vp[1536], vp[8 * 512], vp[9 * 512], vp[10 * 512], vp[11 * 512]);
            o[0][cb] = mfma32(vf, pf[0][ks], o[0][cb]); o[1][cb] = mfma32(vf, pf[1][ks], o[1][cb]); }
}
__device__ __forceinline__ void sample_item(int b, int h, int sp, const bf16* Q, const float* ck, const float* cv, const float* nk, const float* nv, float* SP, LAS char* lds) {
    const int tid = threadIdx.x, lane = tid & 63, r32 = lane & 31, hi = lane >> 5, wid = __builtin_amdgcn_readfirstlane(tid >> 6);
    bf16x8 qf[2][4];
#pragma unroll
    for (int c = 0; c < 2; ++c)
#pragma unroll
        for (int d0 = 0; d0 < 4; ++d0) qf[c][d0] = *(const bf16x8*)(Q + (size_t)(MP + b * 32 + r32) * 512 + h * 128 + c * 64 + 16 * d0 + 8 * hi);
    f32x16 o[2][4];
#pragma unroll
    for (int c = 0; c < 2; ++c)
#pragma unroll
        for (int cb = 0; cb < 4; ++cb) o[c][cb] = f32x16{};
    float mref[2] = {-INFINITY, -INFINITY}, lsum[2] = {0.f, 0.f};
    const size_t key0 = (size_t)b * PASTL + sp * 1024 + wid * 128;
    for (int blk = 0; blk < 4; ++blk) sample_block(ck + (key0 + blk * 32) * 512 + h * 128, cv + (key0 + blk * 32) * 512 + h * 128, qf, o, mref, lsum, r32, hi);
    if (sp == 3 && wid == 7) sample_block(nk + (size_t)b * 32 * 512 + h * 128, nv + (size_t)b * 32 * 512 + h * 128, qf, o, mref, lsum, r32, hi);
    LAS float* mb = (LAS float*)(lds + 131072);
    LAS float* lb = mb + 1024;
    mb[(wid * 2 + 0) * 64 + lane] = mref[0]; mb[(wid * 2 + 1) * 64 + lane] = mref[1];
    __syncthreads();
    float Mx[2];
#pragma unroll
    for (int c = 0; c < 2; ++c) { float m = mb[c * 64 + lane];
#pragma unroll
        for (int w = 1; w < 8; ++w) m = fmaxf(m, mb[(w * 2 + c) * 64 + lane]);
        Mx[c] = m; const float sc = __builtin_amdgcn_exp2f(mref[c] - m); lsum[c] *= sc;
#pragma unroll
        for (int cb = 0; cb < 4; ++cb)
#pragma unroll
            for (int r = 0; r < 16; ++r) o[c][cb][r] *= sc;
        lb[(wid * 2 + c) * 64 + lane] = lsum[c]; }
#pragma unroll
    for (int st = 4; st >= 1; st >>= 1) {
        if (wid >= st && wid < 2 * st) { LAS float* sl = (LAS float*)lds + (size_t)(wid - st) * 8192 + lane;
#pragma unroll
            for (int c = 0; c < 2; ++c)
#pragma unroll
                for (int cb = 0; cb < 4; ++cb)
#pragma unroll
                    for (int r = 0; r < 16; ++r) sl[((c * 4 + cb) * 16 + r) * 64] = o[c][cb][r]; }
        __syncthreads();
        if (wid < st) { const LAS float* sl = (const LAS float*)lds + (size_t)wid * 8192 + lane;
#pragma unroll
            for (int c = 0; c < 2; ++c)
#pragma unroll
                for (int cb = 0; cb < 4; ++cb)
#pragma unroll
                    for (int r = 0; r < 16; ++r) o[c][cb][r] += sl[((c * 4 + cb) * 16 + r) * 64]; }
        __syncthreads();
    }
    if (wid == 0) {
#pragma unroll
        for (int c = 0; c < 2; ++c) { float l = 0.f;
#pragma unroll
            for (int w = 0; w < 8; ++w) l += lb[(w * 2 + c) * 64 + lane];
            l += __shfl_xor(l, 32);
            float* dst = SP + (size_t)(((b * 4 + h) * 4 + sp) * 2 + c) * SPART_FLOATS + lane;
#pragma unroll
            for (int cb = 0; cb < 4; ++cb)
#pragma unroll
                for (int r = 0; r < 16; ++r) dst[(cb * 16 + r) * 64] = o[c][cb][r];
            dst[4096] = Mx[c]; dst[4096 + 64] = l; }
    }
    __syncthreads();
}
__device__ __forceinline__ void sample_combine(int bh, const float* SP, float lam, const float* sg, bf16* ATTN, int lane) {
    const int r32 = lane & 31, hi = lane >> 5;
    float sc[2][4];
#pragma unroll
    for (int c = 0; c < 2; ++c) {
        const float* src = SP + (size_t)((bh * 4) * 2 + c) * SPART_FLOATS + lane;
        float ms[4], m = -INFINITY, l = 0.f;
#pragma unroll
        for (int s = 0; s < 4; ++s) { ms[s] = src[(size_t)s * 2 * SPART_FLOATS + 4096]; m = fmaxf(m, ms[s]); }
#pragma unroll
        for (int s = 0; s < 4; ++s) { sc[c][s] = __builtin_amdgcn_exp2f(ms[s] - m); l += sc[c][s] * src[(size_t)s * 2 * SPART_FLOATS + 4096 + 64]; }
        const float inv = (c == 0 ? 1.0f : -lam) / l;
#pragma unroll
        for (int s = 0; s < 4; ++s) sc[c][s] *= inv;
    }
    f32x16 o[4];
#pragma unroll
    for (int cb = 0; cb < 4; ++cb) { o[cb] = f32x16{};
#pragma unroll
        for (int c = 0; c < 2; ++c)
#pragma unroll
            for (int s = 0; s < 4; ++s) { const float* src = SP + (size_t)((bh * 4 + s) * 2 + c) * SPART_FLOATS + lane;
#pragma unroll
                for (int r = 0; r < 16; ++r) o[cb][r] += sc[c][s] * src[(cb * 16 + r) * 64]; } }
    const int b = bh >> 2, h = bh & 3;
    finish_store(o, sg, ATTN + (size_t)(MP + b * 32 + r32) * 512 + h * 128, hi);
}
}

__device__ __forceinline__ void pool_phase(const bf16* UPOOL, const float* state, bf16* MIXED, int gtid, int nthr) {
    for (int it = gtid; it < M * 64; it += nthr) {
        const int row = it >> 6, cg8 = it & 63, c0 = cg8 * 8, w = 2 << (cg8 >> 4);
        float s[8] = {0.f, 0.f, 0.f, 0.f, 0.f, 0.f, 0.f, 0.f}, self[8]; float cnt;
        { const u32x4 v = *(const u32x4*)(UPOOL + (size_t)row * 512 + c0); self[0] = pg8::bf_lo(v.x); self[1] = pg8::bf_hi(v.x); self[2] = pg8::bf_lo(v.y); self[3] = pg8::bf_hi(v.y);
          self[4] = pg8::bf_lo(v.z); self[5] = pg8::bf_hi(v.z); self[6] = pg8::bf_lo(v.w); self[7] = pg8::bf_hi(v.w); }
        if (row < MP) { const int lo = row - w + 1 < 0 ? 0 : row - w + 1; cnt = (float)(row - lo + 1);
            for (int r = lo; r <= row; ++r) { const u32x4 v = *(const u32x4*)(UPOOL + (size_t)r * 512 + c0);
                s[0] += pg8::bf_lo(v.x); s[1] += pg8::bf_hi(v.x); s[2] += pg8::bf_lo(v.y); s[3] += pg8::bf_hi(v.y); s[4] += pg8::bf_lo(v.z); s[5] += pg8::bf_hi(v.z); s[6] += pg8::bf_lo(v.w); s[7] += pg8::bf_hi(v.w); }
        } else { const int b = (row - MP) >> 5, t = (row - MP) & 31; cnt = (float)w;
            for (int e = 15 + t - w + 1; e <= 15 + t; ++e) {
                if (e < 15) { const float* sp = state + (size_t)(b * 15 + e) * 512 + c0; const f32x4 a = *(const f32x4*)sp, bq = *(const f32x4*)(sp + 4);
                    s[0] += a[0]; s[1] += a[1]; s[2] += a[2]; s[3] += a[3]; s[4] += bq[0]; s[5] += bq[1]; s[6] += bq[2]; s[7] += bq[3]; }
                else { const u32x4 v = *(const u32x4*)(UPOOL + (size_t)(MP + b * 32 + e - 15) * 512 + c0);
                    s[0] += pg8::bf_lo(v.x); s[1] += pg8::bf_hi(v.x); s[2] += pg8::bf_lo(v.y); s[3] += pg8::bf_hi(v.y); s[4] += pg8::bf_lo(v.z); s[5] += pg8::bf_hi(v.z); s[6] += pg8::bf_lo(v.w); s[7] += pg8::bf_hi(v.w); } } }
        const float ic = 1.0f / cnt; u32x4 o;
        o.x = pk2(s[0] * ic - self[0], s[1] * ic - self[1]); o.y = pk2(s[2] * ic - self[2], s[3] * ic - self[3]); o.z = pk2(s[4] * ic - self[4], s[5] * ic - self[5]); o.w = pk2(s[6] * ic - self[6], s[7] * ic - self[7]);
        *(u32x4*)(MIXED + (size_t)row * 512 + c0) = o;
    }
}

#define XB_TMO      128
#define XB_XCNT(j)  (256  + 64 * (j))
#define XB_XSUB(j)  (1280 + 64 * (j))
#define XB_XGEN(j)  (2304 + 64 * (j))
#define XB_TOP      3328
#define XB_TOPGEN   3392
#define XCD_BAR_WORDS 3456
#define XB_SPIN_CAP (1u << 18)

__device__ __forceinline__ unsigned xb_ld(unsigned* p)              { return __hip_atomic_load(p, __ATOMIC_RELAXED, __HIP_MEMORY_SCOPE_AGENT); }
__device__ __forceinline__ unsigned xb_add(unsigned* p, unsigned v) { return __hip_atomic_fetch_add(p, v, __ATOMIC_RELAXED, __HIP_MEMORY_SCOPE_AGENT); }
__device__ __forceinline__ unsigned xb_xcc_id() { return (unsigned)__builtin_amdgcn_s_getreg((3 << 11) | 20) & 0xFu; }
#define XB_SPIN(cond, bar) do { unsigned _sp = 0; while (cond) { __builtin_amdgcn_s_sleep(1); \
    if ((++_sp & 255u) == 0u) { if (xb_ld(&(bar)[XB_TMO])) break; if (_sp > XB_SPIN_CAP) { atomicAdd(&(bar)[XB_TMO], 1u); break; } } } } while (0)

struct XcdBarrier {
    unsigned* bar; unsigned x;
    volatile LAS unsigned* st;
};

__device__ __forceinline__ XcdBarrier xcd_barrier_post(unsigned* bar, volatile LAS unsigned* st) {
    XcdBarrier b; b.bar = bar; b.x = xb_xcc_id(); b.st = st;
    if (threadIdx.x == 0) (void)xb_add(&bar[XB_XCNT(b.x)], 1u);
    return b;
}
__device__ __forceinline__ void xcd_barrier_complete(unsigned* bar, unsigned x, unsigned& nloc, unsigned& nx) {
    const unsigned G = gridDim.x * gridDim.y * gridDim.z;
    unsigned sum, cnt, mine, sp = 0u;
    for (;;) {
        sum = 0u; cnt = 0u; mine = 0u;
#pragma unroll
        for (unsigned j = 0; j < 16; ++j) { const unsigned c = xb_ld(&bar[XB_XCNT(j)]); sum += c; cnt += (c > 0u) ? 1u : 0u; mine = (j == x) ? c : mine; }
        if (sum == G) break;
        __builtin_amdgcn_s_sleep(1);
        if ((++sp & 255u) == 0u) { if (xb_ld(&bar[XB_TMO])) break; if (sp > XB_SPIN_CAP) { atomicAdd(&bar[XB_TMO], 1u); break; } }
    }
    nloc = mine > 0u ? mine : 1u; nx = cnt > 0u ? cnt : 1u;
}

__device__ __forceinline__ void xcd_barrier(const XcdBarrier& b) {
    asm volatile("s_waitcnt vmcnt(0)" ::: "memory");
    __syncthreads();
    if (threadIdx.x == 0) {
        unsigned* bar = b.bar;
        __builtin_amdgcn_s_waitcnt(0);
        unsigned nloc = b.st[0], nx = b.st[1];
        if (nloc == 0u) { xcd_barrier_complete(bar, b.x, nloc, nx); b.st[0] = nloc; b.st[1] = nx; }
        const unsigned old = xb_add(&bar[XB_XSUB(b.x)], 1u);
        const unsigned gen = old / nloc;
        if (old + 1u == (gen + 1u) * nloc) {
            __builtin_amdgcn_fence(__ATOMIC_RELEASE, "agent");
            asm volatile("s_waitcnt vmcnt(0)" ::: "memory");
            const unsigned og = xb_add(&bar[XB_TOP], 1u);
            const unsigned tg = og / nx;
            if (og + 1u == (tg + 1u) * nx) xb_add(&bar[XB_TOPGEN], 1u);
            else XB_SPIN(xb_ld(&bar[XB_TOPGEN]) == tg, bar);
            __builtin_amdgcn_fence(__ATOMIC_ACQUIRE, "agent");
            xb_add(&bar[XB_XGEN(b.x)], 1u);
            asm volatile("s_waitcnt vmcnt(0)" ::: "memory");
        } else {
            XB_SPIN(xb_ld(&bar[XB_XGEN(b.x)]) == gen, bar);
            __builtin_amdgcn_fence(__ATOMIC_ACQUIRE, "agent");
            asm volatile("s_waitcnt vmcnt(0)" ::: "memory");
        }
    }
    __syncthreads();
}

struct Args { const float* in[26]; float* out; unsigned char* ws; double rc[8]; int ph_lo, ph_hi; };
__global__ void __launch_bounds__(512, 2) fwd_mega(Args a) {
    extern __shared__ __attribute__((aligned(16))) unsigned char lds_raw[];
    LAS unsigned char* lds = (LAS unsigned char*)lds_raw;
    cg::grid_group grid = cg::this_grid();
    const int tid = threadIdx.x, lane = tid & 63, wid = __builtin_amdgcn_readfirstlane(tid >> 6);
    const int G = gridDim.x, gw = blockIdx.x * 8 + wid, NGW = G * 8;
    unsigned char* ws = a.ws;
    bf16 *WGU1 = (bf16*)(ws + WS_WGU1), *WD1 = (bf16*)(ws + WS_WD1), *WIN = (bf16*)(ws + WS_WIN), *WC = (bf16*)(ws + WS_WC), *WBA = (bf16*)(ws + WS_WBA), *WOUT = (bf16*)(ws + WS_WOUT), *WGU2 = (bf16*)(ws + WS_WGU2), *WD2 = (bf16*)(ws + WS_WD2);
    bf16 *XN = (bf16*)(ws + WS_XN), *HID = (bf16*)(ws + WS_HID), *UPOOL = (bf16*)(ws + WS_UPOOL), *QB = (bf16*)(ws + WS_Q), *KB = (bf16*)(ws + WS_K), *VT = (bf16*)(ws + WS_VT), *GATES = (bf16*)(ws + WS_GATES), *MIXED = (bf16*)(ws + WS_MIXED), *ATTN = (bf16*)(ws + WS_ATTN);
    float *D = (float*)(ws + WS_D), *H = (float*)(ws + WS_H), *SPART = (float*)(ws + WS_SPART), *DP = (float*)(ws + WS_DP);
    const float *xp = a.in[0], *xs = a.in[1];
    volatile LAS unsigned* MISC = (volatile LAS unsigned*)(lds + LDS_BYTES - 64);
    if (tid < 16) MISC[tid] = 0u;
    __syncthreads();
    unsigned* barw = (unsigned*)ws;
    XcdBarrier bar = xcd_barrier_post(barw, MISC);
    if (a.ph_lo < 0) grid.sync();
    const int lo = a.ph_lo, hi_ = a.ph_hi;
#define IN(k) (lo <= (k) && (k) < hi_)
#define REPEAT(k) for (int rep_ = 0; rep_ < 1 + ((REP_MASK >> (k)) & 1); ++rep_, (rep_ < 1 + ((REP_MASK >> (k)) & 1) ? grid.sync() : (void)0))
#define SEAM(k) do { if (IN(k) && IN((k) + 1)) xcd_barrier(bar); } while (0)

    for (int rz_ = 0; rz_ < SYNC_REP; ++rz_) grid.sync();
    if (IN(0)) REPEAT(0) {
        LAS float* scr = (LAS float*)(lds + wid * 16640);
        transpose_mat(a.in[7], DMODEL, NGU, WGU1, true, gw, NGW, scr, lane);
        transpose_mat(a.in[8], DFF, DMODEL, WD1, false, gw, NGW, scr, lane);
        transpose_mat(a.in[11], DMODEL, 4096, WIN, false, gw, NGW, scr, lane);
        transpose_mat(a.in[20], 512, DMODEL, WBA, false, gw, NGW, scr, lane);
        transpose_mat(a.in[21], DMODEL, DMODEL, WOUT, false, gw, NGW, scr, lane);
        transpose_mat(a.in[24], DMODEL, NGU, WGU2, true, gw, NGW, scr, lane);
        transpose_mat(a.in[25], DFF, DMODEL, WD2, false, gw, NGW, scr, lane);
        { const float *pw = a.in[12], *psc = a.in[13], *wbp = a.in[19];
          for (int it = gw; it < 64 * 16; it += NGW) { const int kg = it >> 4, e = (it & 15) * 64 + lane, g = kg >> 4, cbase = (kg & 15) * 8;
              float acc8[8] = {0.f, 0.f, 0.f, 0.f, 0.f, 0.f, 0.f, 0.f};
              for (int j = 0; j < 128; ++j) { const float wv = wbp[(size_t)(g * 128 + j) * DMODEL + e] * psc[g * 128 + j];
#pragma unroll
                  for (int i = 0; i < 8; ++i) acc8[i] += pw[(size_t)(g * 128 + cbase + i) * 128 + j] * wv; }
              u32x4 o; o.x = pk2(acc8[0], acc8[1]); o.y = pk2(acc8[2], acc8[3]); o.z = pk2(acc8[4], acc8[5]); o.w = pk2(acc8[6], acc8[7]);
              *(u32x4*)(WC + (size_t)e * 512 + g * 128 + cbase) = o; } }
        for (int row = gw; row < M; row += NGW) { const float* xr = xrow_ptr(xp, xs, row); f32x4 v[4];
#pragma unroll
            for (int j = 0; j < 4; ++j) v[j] = *((const f32x4*)xr + lane + 64 * j);
            norm_row_bf16(v, a.in[5], XN + (size_t)row * DMODEL, lane); }
    }
    SEAM(0);
    if (IN(1)) REPEAT(1) { pg8::Gemm g{XN, WGU1, M, NGU, DMODEL}; pg8::StaticOrder S; S.init(M, NGU, G, (int)blockIdx.x, g.K); pg8::EpiSwiglu E{HID, DFF};
        pg8::gemm_phase<pg8::EpiSwiglu, pg8::StaticOrder, true, true>(lds, g, S, E); }
    SEAM(1);
    if (IN(2)) REPEAT(2) { pg8::Gemm g{HID, WD1, M, DMODEL, DFF}; pg8::SplitOrder S; S.init(DMODEL, G, (int)blockIdx.x, g.K, 11); pg8::EpiF32 E{D, DMODEL, DP};
        pg8::gemm_phase<pg8::EpiF32, pg8::SplitOrder, true, true>(lds, g, S, E); }
    SEAM(2);
    if (IN(3)) REPEAT(3) resnorm_rows(xp, xs, nullptr, D, DP, 11, 0.5f, a.in[6], H, a.in[9], XN, gw, NGW, lane);
    SEAM(3);
    if (IN(4)) REPEAT(4) { pg8::Gemm g{XN, WIN, M, 4096, DMODEL}; pg8::StaticOrder S; S.init(M, 4096, G, (int)blockIdx.x, g.K);
        pg8::EpiWin E{UPOOL, QB, KB, VT, GATES, a.out, {a.rc[0], a.rc[1], a.rc[2], a.rc[3], a.rc[4], a.rc[5], a.rc[6], a.rc[7]}};
        pg8::gemm_phase<pg8::EpiWin, pg8::StaticOrder, true, true>(lds, g, S, E); }
    SEAM(4);
    if (IN(5)) REPEAT(5) {
        for (int rq_ = 0; rq_ < POOL_REP; ++rq_) pool_phase(UPOOL, a.in[4], MIXED, blockIdx.x * 512 + tid, G * 512);
        const float lam = compute_lam(a.in[14], a.in[15], a.in[16], a.in[17], lane);
        for (int rs_ = 0; rs_ < SAMP_REP; ++rs_)
        for (int it = blockIdx.x; it < 256; it += G) att::sample_item(it >> 4, (it >> 2) & 3, it & 3, QB, a.in[2], a.in[3], a.out + OFF_KS, a.out + OFF_VS, SPART, (LAS char*)lds);
        for (int rp_ = 0; rp_ < ATT_REP; ++rp_)
        for (int p = blockIdx.x; p < 256; p += G) { const int h = p >> 6, s = p & 63;
            att::prompt_unit(h, 127 - s, QB, KB, VT, ATTN, lam, a.in[18], (LAS char*)lds);
            att::prompt_unit(h, s, QB, KB, VT, ATTN, lam, a.in[18], (LAS char*)lds); }
    }
    SEAM(5);
    if (IN(6)) REPEAT(6) { const float lam = compute_lam(a.in[14], a.in[15], a.in[16], a.in[17], lane);
        for (int bh = gw; bh < 64; bh += NGW) att::sample_combine(bh, SPART, lam, a.in[18], ATTN, lane); }
    SEAM(6);
    if (IN(7)) REPEAT(7) { pg8::Gemm g{MIXED, WC, M, DMODEL, 512}; pg8::StaticOrder S; S.init(M, DMODEL, G, (int)blockIdx.x, g.K); pg8::EpiMergeA E{GATES, D};
        pg8::gemm_phase<pg8::EpiMergeA, pg8::StaticOrder, true, true>(lds, g, S, E); }
    if (IN(8)) REPEAT(8) { pg8::Gemm g{ATTN, WBA, M, DMODEL, 512}; pg8::StaticOrder S; S.init(M, DMODEL, G, (int)blockIdx.x, g.K); pg8::EpiMergeB E{GATES, D, XN};
        pg8::gemm_phase<pg8::EpiMergeB, pg8::StaticOrder, true, true>(lds, g, S, E); }
    SEAM(8);
    if (IN(9)) REPEAT(9) { pg8::Gemm g{XN, WOUT, M, DMODEL, DMODEL}; pg8::SplitOrder S; S.init(DMODEL, G, (int)blockIdx.x, g.K, 4); pg8::EpiF32 E{D, DMODEL, DP};
        pg8::gemm_phase<pg8::EpiF32, pg8::SplitOrder, true, true>(lds, g, S, E); }
    SEAM(9);
    if (IN(10)) REPEAT(10) resnorm_rows(xp, xs, H, D, DP, 4, 1.0f, a.in[10], H, a.in[22], XN, gw, NGW, lane);
    SEAM(10);
    if (IN(11)) REPEAT(11) { pg8::Gemm g{XN, WGU2, M, NGU, DMODEL}; pg8::StaticOrder S; S.init(M, NGU, G, (int)blockIdx.x, g.K); pg8::EpiSwiglu E{HID, DFF};
        pg8::gemm_phase<pg8::EpiSwiglu, pg8::StaticOrder, true, true>(lds, g, S, E); }
    SEAM(11);
    if (IN(12)) REPEAT(12) { pg8::Gemm g{HID, WD2, M, DMODEL, DFF}; pg8::SplitOrder S; S.init(DMODEL, G, (int)blockIdx.x, g.K, 11); pg8::EpiF32 E{D, DMODEL, DP};
        pg8::gemm_phase<pg8::EpiF32, pg8::SplitOrder, true, true>(lds, g, S, E); }
    SEAM(12);
    if (IN(13)) REPEAT(13) resnorm_rows(xp, xs, H, D, DP, 11, 0.5f, a.in[23], a.out, nullptr, nullptr, gw, NGW, lane);
#undef IN
#undef SEAM
}

#ifndef N_LAUNCH_PER_PHASE
#define N_LAUNCH_PER_PHASE 0
#endif
extern "C" void kernel_launch(void* const* d_in, const int* in_sizes, int n_in, void* d_out, int out_size, void* d_ws, size_t ws_size, hipStream_t stream) {
    static int grid = 0;
    if (grid == 0) {
        if (n_in != 26 || (size_t)out_size != OUT_TOTAL || ws_size < WS_END) { fprintf(stderr, "kernel_launch: unexpected sizes n_in %d out %d ws %zu\n", n_in, out_size, ws_size); grid = -1; return; }
        int dev = 0, cus = 0, per_cu = 0;
        hipGetDevice(&dev); hipDeviceGetAttribute(&cus, hipDeviceAttributeMultiprocessorCount, dev);
        hipFuncSetAttribute((const void*)fwd_mega, hipFuncAttributeMaxDynamicSharedMemorySize, LDS_BYTES);
        hipOccupancyMaxActiveBlocksPerMultiprocessor(&per_cu, (const void*)fwd_mega, 512, LDS_BYTES);
        if (per_cu < 1) { fprintf(stderr, "kernel_launch: occupancy query says %d\n", per_cu); per_cu = 1; }
        (void)hipGetLastError();
        grid = cus * (per_cu > 1 ? 1 : per_cu);
    }
    if (grid < 0) return;
    Args a{};
    for (int i = 0; i < 26; ++i) a.in[i] = (const float*)d_in[i];
    a.out = (float*)d_out; a.ws = (unsigned char*)d_ws;
    for (int i = 0; i < 8; ++i) a.rc[i] = pow(500000.0, -(double)i / 8.0) / (2.0 * M_PI);
#if N_LAUNCH_PER_PHASE
    for (int p = 0; p < NPH; ++p) { a.ph_lo = p; a.ph_hi = p + 1; hipLaunchKernelGGL(fwd_mega, dim3(grid), dim3(512), LDS_BYTES, stream, a); }
#else
    a.ph_lo = 0; a.ph_hi = NPH;
    if (hipMemsetAsync(d_ws, 0, XCD_BAR_WORDS * sizeof(unsigned), stream) != hipSuccess) { fprintf(stderr, "kernel_launch: memset of the barrier words failed\n"); return; }
    void* args[] = {&a};
    hipError_t e = hipLaunchCooperativeKernel((const void*)fwd_mega, dim3(grid), dim3(512), args, LDS_BYTES, stream);
    if (e != hipSuccess) fprintf(stderr, "cooperative launch failed: %s (grid %d)\n", hipGetErrorString(e), grid);
#endif
}
```

```cpp
#include <hip/hip_runtime.h>
#include <hip/hip_cooperative_groups.h>
#include <cstdio>
#include <cstdint>
#include <cmath>
namespace cg = cooperative_groups;
namespace pg8 {
#define PG8_LAS __attribute__((address_space(3)))
typedef unsigned short bf16_t;
typedef short bf16x8 __attribute__((ext_vector_type(8)));
typedef float f32x4 __attribute__((ext_vector_type(4)));
typedef unsigned u32x4 __attribute__((ext_vector_type(4)));
constexpr int BM = 256, BK = 64, HALF = 128, HTB = HALF * BK * 2  , STAGE_BYTES = 8 * HTB, NXCD = 8, WGM = 8;

__host__ __device__ __forceinline__ int lds_byte(int r, int c) { const int st = (r >> 4) * 2 + (c >> 5), rr = r & 15, cc = c & 31, ob = rr * 64 + cc * 2; return st * 1024 + (ob ^ (((ob >> 9) & 1) << 5)); }
__host__ __device__ __forceinline__ void stage_rc(int b, int& R, int& C) { const int st = b / 1024, sb = b % 1024, swz = sb ^ (((sb >> 9) & 1) << 5); R = (st >> 1) * 16 + swz / 64; C = (st & 1) * 32 + (swz % 64) / 2; }
__host__ __device__ __forceinline__ int perm32(int rho) { const int n = rho >> 4, i = rho & 15; return 8 * (i >> 2) + 4 * n + (i & 3); }

struct Unit { int pm, pn, ks; };
struct Gemm { const bf16_t* A; const bf16_t* Bt; int M, N, K; };

struct StaticOrder {
    int nM, nN, nwg, G, c, ntk;
    __host__ __device__ void init(int M, int N, int G_, int c_, int K_) { nM = M / BM; nN = N / BM; nwg = nM * nN; G = G_; c = c_; ntk = K_ / BK; }
    __host__ __device__ bool next(int i, Unit& u) const {
        const long L = (long)i * G + c; if (L >= nwg) return false;
        int wgid = (int)L; { const int q = nwg / NXCD, r = nwg % NXCD, xcd = wgid % NXCD, off = wgid / NXCD; wgid = (xcd < r ? xcd * (q + 1) : r * (q + 1) + (xcd - r) * q) + off; }
        const int nig = WGM * nN, gid = wgid / nig, fm = gid * WGM, gsz = (nM - fm) < WGM ? (nM - fm) : WGM;
        u.pm = fm + ((wgid % nig) % gsz); u.pn = (wgid % nig) / gsz; u.ks = 0; return true;
    }
    __device__ __forceinline__ void a_ready(const Unit&) const {}
    __device__ __forceinline__ void done(const Unit&) const {}
    __device__ __forceinline__ int nt(const Unit&) const { return ntk; }
    __device__ __forceinline__ int kt0(const Unit&) const { return 0; }
};
struct SplitOrder {
    StaticOrder so; int S, ntk, c;
    __host__ __device__ void init(int N, int G_, int c_, int K_, int S_) { so.init(64 * BM, N, G_, c_, K_); S = S_; ntk = K_ / BK; c = c_; }
    __host__ __device__ bool next(int i, Unit& u) const {
        const int L = i * so.G + c;
        if (L >= so.nwg + 8 * S) return false;
        Unit t; t.pm = 0; t.pn = 0; t.ks = 0; (void)so.next(i, t);
        const int j = L - so.nwg, tile = j / S, sp = (int)(L >= so.nwg);
        u.pm = sp ? 64 + (tile >> 2) : t.pm; u.pn = sp ? (tile & 3) : t.pn; u.ks = sp ? j - tile * S : 0; return true;
    }
    __device__ __forceinline__ void a_ready(const Unit&) const {}
    __device__ __forceinline__ void done(const Unit&) const {}
    __device__ __forceinline__ int nt(const Unit& u) const { const int sp = (int)(u.pm >= 64), nts = ntk / S; return ntk - sp * (ntk - nts); }
    __device__ __forceinline__ int kt0(const Unit& u) const { const int sp = (int)(u.pm >= 64); return sp * u.ks * (ntk / S); }
};

__device__ __forceinline__ unsigned cvt_pk_bf16(float lo, float hi) { unsigned r; asm volatile("v_cvt_pk_bf16_f32 %0, %1, %2" : "=v"(r) : "v"(lo), "v"(hi)); return r; }
typedef float f32x2 __attribute__((ext_vector_type(2)));
__device__ __forceinline__ float sigm(float x) { return __builtin_amdgcn_rcpf(1.f + __builtin_amdgcn_exp2f(-1.4426950408889634f * x)); }
__device__ __forceinline__ float bf_lo(unsigned w) { return __uint_as_float(w << 16); }
__device__ __forceinline__ float bf_hi(unsigned w) { return __uint_as_float(w & 0xffff0000u); }
__device__ __forceinline__ u32x4 pack8(const f32x4 a, const f32x4 b) { u32x4 w; w.x = cvt_pk_bf16(a[0], a[1]); w.y = cvt_pk_bf16(a[2], a[3]); w.z = cvt_pk_bf16(b[0], b[1]); w.w = cvt_pk_bf16(b[2], b[3]); return w; }

struct EpiSwiglu {
    static constexpr bool PERM = true, AFTER_DRAIN = false;
    bf16_t* O; int ldc;
    __device__ __forceinline__ void operator()(const f32x4 (&acc)[2][2][4][2], const Unit& u, int wr, int wc, int fr, int fq) const {
        const int row0 = u.pm * BM + wr * 64 + fr, col0 = u.pn * HALF + wc * 32 + 8 * fq;
#pragma unroll
        for (int ai = 0; ai < 2; ++ai)
#pragma unroll
            for (int m = 0; m < 4; ++m) {
                f32x4 h0, h1;
#pragma unroll
                for (int i = 0; i < 4; ++i) { const float g0 = acc[ai][0][m][0][i], g1 = acc[ai][0][m][1][i]; h0[i] = g0 * sigm(g0) * acc[ai][1][m][0][i]; h1[i] = g1 * sigm(g1) * acc[ai][1][m][1][i]; }
                *(u32x4*)(O + (size_t)(row0 + ai * HALF + m * 16) * ldc + col0) = pack8(h0, h1);
            }
    }
};
struct EpiF32 {
    static constexpr bool PERM = false, AFTER_DRAIN = false;
    float* O; int ldc; float* DP;
    __device__ __forceinline__ void operator()(const f32x4 (&acc)[2][2][4][2], const Unit& u, int wr, int wc, int fr, int fq) const {
        const int row0 = u.pm * BM + wr * 64 + fr, col0 = u.pn * BM + wc * 32 + 4 * fq;
        float* base = (DP && u.pm >= 64) ? DP + ((size_t)u.ks * 512 - 16384) * 1024 : O;
#pragma unroll
        for (int ai = 0; ai < 2; ++ai)
#pragma unroll
            for (int m = 0; m < 4; ++m) { float* rp = base + (size_t)(row0 + ai * HALF + m * 16) * ldc + col0;
#pragma unroll
                for (int bj = 0; bj < 2; ++bj)
#pragma unroll
                    for (int n = 0; n < 2; ++n) *(f32x4*)(rp + bj * HALF + n * 16) = acc[ai][bj][m][n]; }
    }
};
struct EpiMergeA {
    static constexpr bool PERM = true, AFTER_DRAIN = false;
    const bf16_t* G; float* MG;
    __device__ __forceinline__ void operator()(const f32x4 (&acc)[2][2][4][2], const Unit& u, int wr, int wc, int fr, int fq) const {
        const int row0 = u.pm * BM + wr * 64 + fr, col0 = u.pn * BM + wc * 32 + 8 * fq;
#pragma unroll
        for (int ai = 0; ai < 2; ++ai)
#pragma unroll
            for (int m = 0; m < 4; ++m) { const size_t row = (size_t)(row0 + ai * HALF + m * 16);
#pragma unroll
                for (int bj = 0; bj < 2; ++bj) { const int c0 = col0 + bj * HALF; const u32x4 g = *(const u32x4*)(G + row * 2048 + c0);
                    const f32x4 a = acc[ai][bj][m][0], b = acc[ai][bj][m][1];
                    f32x4 o0 = {a[0] * bf_lo(g.x), a[1] * bf_hi(g.x), a[2] * bf_lo(g.y), a[3] * bf_hi(g.y)}, o1 = {b[0] * bf_lo(g.z), b[1] * bf_hi(g.z), b[2] * bf_lo(g.w), b[3] * bf_hi(g.w)};
                    *(f32x4*)(MG + row * 1024 + c0) = o0; *(f32x4*)(MG + row * 1024 + c0 + 4) = o1; } }
    }
};
struct EpiMergeB {
    static constexpr bool PERM = true, AFTER_DRAIN = false;
    const bf16_t* G; const float* MG; bf16_t* O;
    __device__ __forceinline__ void operator()(const f32x4 (&acc)[2][2][4][2], const Unit& u, int wr, int wc, int fr, int fq) const {
        const int row0 = u.pm * BM + wr * 64 + fr, col0 = u.pn * BM + wc * 32 + 8 * fq;
#pragma unroll
        for (int ai = 0; ai < 2; ++ai)
#pragma unroll
            for (int m = 0; m < 4; ++m) { const size_t row = (size_t)(row0 + ai * HALF + m * 16);
#pragma unroll
                for (int bj = 0; bj < 2; ++bj) { const int c0 = col0 + bj * HALF; const u32x4 g = *(const u32x4*)(G + row * 2048 + 1024 + c0);
                    const f32x4 m0 = *(const f32x4*)(MG + row * 1024 + c0), m1 = *(const f32x4*)(MG + row * 1024 + c0 + 4);
                    const f32x4 a = acc[ai][bj][m][0], b = acc[ai][bj][m][1];
                    f32x4 o0 = {m0[0] + a[0] * bf_lo(g.x), m0[1] + a[1] * bf_hi(g.x), m0[2] + a[2] * bf_lo(g.y), m0[3] + a[3] * bf_hi(g.y)};
                    f32x4 o1 = {m1[0] + b[0] * bf_lo(g.z), m1[1] + b[1] * bf_hi(g.z), m1[2] + b[2] * bf_lo(g.w), m1[3] + b[3] * bf_hi(g.w)};
                    *(u32x4*)(O + row * 1024 + c0) = pack8(o0, o1); } }
    }
};
constexpr int EW_MP = 16384;
constexpr size_t EW_OFF_KP = 17301504, EW_OFF_VP = 25690112, EW_OFF_PP = 34078720, EW_OFF_KS = 34086400, EW_OFF_VS = 34348544, EW_OFF_PS = 34610688;
struct EpiWin {
    static constexpr bool PERM = true, AFTER_DRAIN = false;
    bf16_t *UPOOL, *Q, *K, *VT, *GATES; float* out; double rc[8];
    __device__ __forceinline__ void operator()(const f32x4 (&acc)[2][2][4][2], const Unit& u, int wr, int wc, int fr, int fq) const {
        const int pn = u.pn, row0 = u.pm * BM + wr * 64 + fr, cl = wc * 32 + 8 * fq;
        if (pn < 2) {
#pragma unroll
            for (int ai = 0; ai < 2; ++ai)
#pragma unroll
                for (int m = 0; m < 4; ++m) { const int row = row0 + ai * HALF + m * 16;
                    long po = -1;
                    if (row >= EW_MP - 15 && row < EW_MP) po = (long)EW_OFF_PP + (long)(row - (EW_MP - 15)) * 512;
                    else if (row >= EW_MP) { const int t = (row - EW_MP) & 31, b = (row - EW_MP) >> 5; if (t >= 17) po = (long)EW_OFF_PS + (long)(b * 15 + t - 17) * 512; }
#pragma unroll
                    for (int bj = 0; bj < 2; ++bj) { const int c0 = pn * BM + bj * HALF + cl;
                        *(u32x4*)(UPOOL + (size_t)row * 512 + c0) = pack8(acc[ai][bj][m][0], acc[ai][bj][m][1]);
                        if (po >= 0) { *(f32x4*)(out + po + c0) = acc[ai][bj][m][0]; *(f32x4*)(out + po + c0 + 4) = acc[ai][bj][m][1]; } } }
        } else if (pn < 6) {
            const bool is_k = pn >= 4; const bool ropew = (wc & 1) == 0;
#pragma unroll
            for (int ai = 0; ai < 2; ++ai)
#pragma unroll
                for (int m = 0; m < 4; ++m) { const int row = row0 + ai * HALF + m * 16;
                    f32x4 v[2][2] = {{acc[ai][0][m][0], acc[ai][0][m][1]}, {acc[ai][1][m][0], acc[ai][1][m][1]}};
                    if (ropew) {
                        const double pos = (double)(row < EW_MP ? row : 4096 + ((row - EW_MP) & 31));
#pragma unroll
                        for (int n = 0; n < 2; ++n)
#pragma unroll
                            for (int i = 0; i < 4; ++i) { const double rev = pos * rc[n * 4 + i]; const float f = (float)(rev - __builtin_rint(rev));
                                const float sn = __builtin_amdgcn_sinf(f), cs = __builtin_amdgcn_cosf(f);
#pragma unroll
                                for (int bj = 0; bj < 2; ++bj) { const float x = v[bj][n][i], p = __shfl_xor(x, 16);
                                    const float r = (fq == 0) ? x * cs - p * sn : x * cs + p * sn; v[bj][n][i] = (fq < 2) ? r : x; } }
                    }
#pragma unroll
                    for (int bj = 0; bj < 2; ++bj) { const int cq = (pn & 1) * BM + bj * HALF + cl;
                        const float qs = is_k ? 1.0f : 0.18033688011112042f;
                        *(u32x4*)((is_k ? K : Q) + (size_t)row * 512 + cq) = pack8(v[bj][0] * qs, v[bj][1] * qs);
                        if (is_k) { float* o = out + (row < EW_MP ? EW_OFF_KP + (size_t)row * 512 : EW_OFF_KS + (size_t)(row - EW_MP) * 512) + cq; *(f32x4*)o = v[bj][0]; *(f32x4*)(o + 4) = v[bj][1]; } } }
        } else if (pn < 8) {
#pragma unroll
            for (int ai = 0; ai < 2; ++ai)
#pragma unroll
                for (int m = 0; m < 4; ++m) { const int row = row0 + ai * HALF + m * 16;
                    const int k16 = row & 15, tp = (row & ~15) | ((k16 & 3) + ((k16 >> 3) & 1) * 4 + ((k16 >> 2) & 1) * 8);
#pragma unroll
                    for (int bj = 0; bj < 2; ++bj) { const int cv = (pn & 1) * BM + bj * HALF + cl;
                        float* o = out + (row < EW_MP ? EW_OFF_VP + (size_t)row * 512 : EW_OFF_VS + (size_t)(row - EW_MP) * 512) + cv; *(f32x4*)o = acc[ai][bj][m][0]; *(f32x4*)(o + 4) = acc[ai][bj][m][1];
                        if (row < EW_MP) { const u32x4 w = pack8(acc[ai][bj][m][0], acc[ai][bj][m][1]); bf16_t* vp = VT + (size_t)cv * EW_MP + tp;
                            vp[0] = (bf16_t)w.x; vp[EW_MP] = (bf16_t)(w.x >> 16); vp[2 * EW_MP] = (bf16_t)w.y; vp[3 * EW_MP] = (bf16_t)(w.y >> 16);
                            vp[4 * EW_MP] = (bf16_t)w.z; vp[5 * EW_MP] = (bf16_t)(w.z >> 16); vp[6 * EW_MP] = (bf16_t)w.w; vp[7 * EW_MP] = (bf16_t)(w.w >> 16); } } }
        } else {
#pragma unroll
            for (int ai = 0; ai < 2; ++ai)
#pragma unroll
                for (int m = 0; m < 4; ++m) { const int row = row0 + ai * HALF + m * 16;
#pragma unroll
                    for (int bj = 0; bj < 2; ++bj) { const int c0 = (pn - 8) * BM + bj * HALF + cl; f32x4 a = acc[ai][bj][m][0], b = acc[ai][bj][m][1];
#pragma unroll
                        for (int i = 0; i < 4; ++i) { a[i] = sigm(a[i]); b[i] = sigm(b[i]); }
                        *(u32x4*)(GATES + (size_t)row * 2048 + c0) = pack8(a, b); } }
        }
    }
};
template <class Epi, class Sched, bool ALIGN_EPI = false, bool SP2 = false>
__device__ __forceinline__ void gemm_phase(PG8_LAS unsigned char* lds, const Gemm g, const Sched& S, const Epi& E) {
    const int tid = threadIdx.x, wid = __builtin_amdgcn_readfirstlane(tid >> 6), lane = tid & 63, wr = wid >> 2, wc = wid & 3, fr = lane & 15, fq = lane >> 4;
    const int K = g.K; int nt;
    unsigned voffA[2], voffB[2];
#pragma unroll
    for (int i = 0; i < 2; ++i) { int R, C; stage_rc(tid * 16 + i * 8192, R, C); const int Rb = Epi::PERM ? ((R & ~31) + perm32(R & 31)) : R;
        voffA[i] = (unsigned)(R * K + C) * 2u; voffB[i] = (unsigned)(Rb * K + C) * 2u; }
    const size_t kstep = (size_t)(BK * 2);
    const size_t hstep = (size_t)HALF * K * 2;
    const size_t tstep = 2 * hstep;
    const unsigned ldsw = (unsigned)wid * 1024u;
    const int aoff = lds_byte(wr * 64 + fr, fq * 8), boff = lds_byte(wc * 32 + fr, fq * 8);
#define PG8_SA(b, h) (((b) * 2 + (h)) * HTB)
#define PG8_SB(b, h) ((4 + (b) * 2 + (h)) * HTB)
#define PG8_STAGE(bufoff, gbase, voff) do { _Pragma("unroll") for (int _i = 0; _i < 2; ++_i) \
        __builtin_amdgcn_global_load_lds((const unsigned*)((const char*)(gbase) + (voff)[_i]), (PG8_LAS unsigned*)(lds + (bufoff) + ldsw + _i * 8192), 16, 0, 0); } while (0)
#define PG8_LDA(dst, b, h) do { _Pragma("unroll") for (int m = 0; m < 4; ++m) _Pragma("unroll") for (int k = 0; k < 2; ++k) dst[m][k] = *(const PG8_LAS bf16x8*)(lds + PG8_SA(b, h) + aoff + m * 2048 + k * 1024); } while (0)
#define PG8_LDB(dst, b, h) do { _Pragma("unroll") for (int n = 0; n < 2; ++n) _Pragma("unroll") for (int k = 0; k < 2; ++k) dst[n][k] = *(const PG8_LAS bf16x8*)(lds + PG8_SB(b, h) + boff + n * 2048 + k * 1024); } while (0)
#define PG8_MMA(ai, bj, At, Bt) do { __builtin_amdgcn_s_setprio(1); _Pragma("unroll") for (int m = 0; m < 4; ++m) _Pragma("unroll") for (int n = 0; n < 2; ++n) _Pragma("unroll") for (int k = 0; k < 2; ++k) \
        acc[ai][bj][m][n] = __builtin_amdgcn_mfma_f32_16x16x32_bf16(Bt[n][k], At[m][k], acc[ai][bj][m][n], 0, 0, 0); __builtin_amdgcn_s_setprio(0); } while (0)
#define PG8_WAIT_V(n) asm volatile("s_waitcnt vmcnt(" #n ")" ::: "memory")
#define PG8_WAIT_L(n) asm volatile("s_waitcnt lgkmcnt(" #n ")" ::: "memory")
#define PG8_BAR __builtin_amdgcn_s_barrier()
#define PG8_SCHED __builtin_amdgcn_sched_barrier(0)
    Unit cur, nxt; int ui = 0;
    if (!S.next(0, cur)) return;
    f32x4 acc[2][2][4][2];
#pragma unroll
    for (int a = 0; a < 2; ++a)
#pragma unroll
        for (int b = 0; b < 2; ++b)
#pragma unroll
            for (int m = 0; m < 4; ++m)
#pragma unroll
                for (int n = 0; n < 2; ++n) acc[a][b][m][n] = (f32x4){0.f, 0.f, 0.f, 0.f};
    bf16x8 At[4][2], B0[2][2], B1[2][2];
    const char* cA = (const char*)g.A + (size_t)cur.pm * tstep + (size_t)S.kt0(cur) * kstep; const char* cB = (const char*)g.Bt + (size_t)cur.pn * tstep + (size_t)S.kt0(cur) * kstep; nt = S.nt(cur);
    S.a_ready(cur);
    if constexpr (SP2) {
        PG8_STAGE(PG8_SB(0, 0), cB, voffB); PG8_STAGE(PG8_SB(0, 1), cB + hstep, voffB); PG8_STAGE(PG8_SA(0, 0), cA, voffA); PG8_STAGE(PG8_SA(0, 1), cA + hstep, voffA);
        if (wr == 1) PG8_BAR;
        PG8_WAIT_V(2); PG8_BAR;
        PG8_STAGE(PG8_SB(1, 0), cB + kstep, voffB); PG8_STAGE(PG8_SA(1, 0), cA + kstep, voffA); PG8_STAGE(PG8_SB(1, 1), cB + hstep + kstep, voffB);
        PG8_WAIT_V(6); PG8_BAR;
    } else {
        PG8_STAGE(PG8_SB(0, 0), cB, voffB); PG8_STAGE(PG8_SA(0, 0), cA, voffA); PG8_STAGE(PG8_SB(0, 1), cB + hstep, voffB); PG8_STAGE(PG8_SA(0, 1), cA + hstep, voffA);
        if (wr == 1) PG8_BAR;
        PG8_WAIT_V(4); PG8_BAR;
        PG8_STAGE(PG8_SB(1, 0), cB + kstep, voffB); PG8_STAGE(PG8_SA(1, 0), cA + kstep, voffA); PG8_STAGE(PG8_SB(1, 1), cB + hstep + kstep, voffB);
        PG8_WAIT_V(6); PG8_BAR;
    }
    for (;;) {
        const bool has_next = S.next(ui + 1, nxt);
        const char* nA = has_next ? (const char*)g.A + (size_t)nxt.pm * tstep + (size_t)S.kt0(nxt) * kstep : cA; const char* nB = has_next ? (const char*)g.Bt + (size_t)nxt.pn * tstep + (size_t)S.kt0(nxt) * kstep : cB;
        for (int t = 0; t < nt; t += 2) {
            const bool last = (t == nt - 2);
            const char* a1 = cA + (size_t)(t + 1) * kstep;
            const char* a2 = last ? nA : cA + (size_t)(t + 2) * kstep; const char* b2 = last ? nB : cB + (size_t)(t + 2) * kstep;
            const char* a3 = a2 + kstep; const char* b3 = b2 + kstep;
            if (last && has_next) S.a_ready(nxt);
            if constexpr (SP2) {
            PG8_LDB(B0, 0, 0); PG8_LDB(B1, 0, 1); PG8_SCHED; PG8_LDA(At, 0, 0); PG8_STAGE(PG8_SA(1, 1), a1 + hstep, voffA);
            PG8_WAIT_V(8); PG8_WAIT_L(0); PG8_BAR; PG8_MMA(0, 0, At, B0); PG8_MMA(0, 1, At, B1); PG8_BAR; PG8_SCHED;
            PG8_LDA(At, 0, 1); PG8_STAGE(PG8_SB(0, 0), b2, voffB); PG8_STAGE(PG8_SB(0, 1), b2 + hstep, voffB); PG8_STAGE(PG8_SA(0, 0), a2, voffA);
            PG8_WAIT_V(8); PG8_WAIT_L(0); PG8_BAR; PG8_MMA(1, 0, At, B0); PG8_MMA(1, 1, At, B1); PG8_BAR; PG8_SCHED;
            PG8_LDB(B0, 1, 0); PG8_LDB(B1, 1, 1); PG8_SCHED; PG8_LDA(At, 1, 0); PG8_STAGE(PG8_SA(0, 1), a2 + hstep, voffA);
            PG8_WAIT_V(8); PG8_WAIT_L(0); PG8_BAR; PG8_MMA(0, 0, At, B0); PG8_MMA(0, 1, At, B1); PG8_BAR; PG8_SCHED;
            PG8_LDA(At, 1, 1); PG8_STAGE(PG8_SB(1, 0), b3, voffB); PG8_STAGE(PG8_SB(1, 1), b3 + hstep, voffB); PG8_STAGE(PG8_SA(1, 0), a3, voffA);
            PG8_WAIT_V(8); PG8_WAIT_L(0); PG8_BAR; PG8_MMA(1, 0, At, B0); PG8_MMA(1, 1, At, B1); PG8_BAR; PG8_SCHED;
            } else {
            PG8_LDB(B0, 0, 0); PG8_SCHED; PG8_LDA(At, 0, 0); PG8_STAGE(PG8_SA(1, 1), a1 + hstep, voffA);
            PG8_WAIT_L(8); PG8_BAR; PG8_WAIT_L(0); PG8_MMA(0, 0, At, B0); PG8_BAR; PG8_SCHED;
            PG8_LDB(B1, 0, 1); PG8_STAGE(PG8_SB(0, 0), b2, voffB);
            PG8_BAR; PG8_WAIT_L(0); PG8_MMA(0, 1, At, B1); PG8_BAR;
            PG8_LDA(At, 0, 1); PG8_STAGE(PG8_SA(0, 0), a2, voffA);
            PG8_BAR; PG8_WAIT_L(0); PG8_MMA(1, 0, At, B0); PG8_BAR; PG8_SCHED;
            PG8_STAGE(PG8_SB(0, 1), b2 + hstep, voffB);
            PG8_WAIT_V(6); PG8_BAR; PG8_MMA(1, 1, At, B1); PG8_BAR;
            PG8_LDB(B0, 1, 0); PG8_SCHED; PG8_LDA(At, 1, 0); PG8_STAGE(PG8_SA(0, 1), a2 + hstep, voffA);
            PG8_WAIT_L(8); PG8_BAR; PG8_WAIT_L(0); PG8_MMA(0, 0, At, B0); PG8_BAR; PG8_SCHED;
            PG8_LDB(B1, 1, 1); PG8_STAGE(PG8_SB(1, 0), b3, voffB);
            PG8_BAR; PG8_WAIT_L(0); PG8_MMA(0, 1, At, B1); PG8_BAR;
            PG8_LDA(At, 1, 1); PG8_STAGE(PG8_SA(1, 0), a3, voffA);
            PG8_BAR; PG8_WAIT_L(0); PG8_MMA(1, 0, At, B0); PG8_BAR; PG8_SCHED;
            PG8_STAGE(PG8_SB(1, 1), b3 + hstep, voffB);
            PG8_WAIT_V(6); PG8_BAR; PG8_MMA(1, 1, At, B1); PG8_BAR;
            }
        }
        if constexpr (ALIGN_EPI) { if (wr == 0) PG8_BAR; }
        if constexpr (!Epi::AFTER_DRAIN) { E(acc, cur, wr, wc, fr, fq); S.done(cur); }
        if (!has_next) break;
#pragma unroll
        for (int a = 0; a < 2; ++a)
#pragma unroll
            for (int b = 0; b < 2; ++b)
#pragma unroll
                for (int m = 0; m < 4; ++m)
#pragma unroll
                    for (int n = 0; n < 2; ++n) acc[a][b][m][n] = (f32x4){0.f, 0.f, 0.f, 0.f};
        cur = nxt; cA = nA; cB = nB; nt = S.nt(cur); ++ui;
        if constexpr (ALIGN_EPI) { if (wr == 1) PG8_BAR; }
    }
    PG8_WAIT_V(0);
    if constexpr (!ALIGN_EPI) { if (wr == 0) PG8_BAR; }
    PG8_BAR;
    if constexpr (Epi::AFTER_DRAIN) { E.fused(acc, cur, wr, wc, fr, fq, lds, wid, lane); S.done(cur); }
#undef PG8_SA
#undef PG8_SB
#undef PG8_STAGE
#undef PG8_LDA
#undef PG8_LDB
#undef PG8_MMA
#undef PG8_WAIT_V
#undef PG8_WAIT_L
#undef PG8_BAR
#undef PG8_SCHED
}
}
#define LAS __attribute__((address_space(3)))
typedef unsigned short bf16;
typedef short bf16x8 __attribute__((ext_vector_type(8)));
typedef float f32x4 __attribute__((ext_vector_type(4)));
typedef float f32x16 __attribute__((ext_vector_type(16)));
typedef unsigned u32x4 __attribute__((ext_vector_type(4)));
typedef unsigned u32x2 __attribute__((ext_vector_type(2)));

constexpr int DMODEL = 1024, MP = 16384, MS = 512, M = MP + MS, DFF = 2816, NGU = 2 * DFF, PASTL = 4096;
constexpr float EPS = 1e-6f, LAM_INIT = 0.2f;
constexpr size_t OFF_KP = 17301504, OFF_VP = 25690112, OFF_PP = 34078720, OFF_KS = 34086400, OFF_VS = 34348544, OFF_PS = 34610688, OUT_TOTAL = 34733568;
constexpr size_t MiB = 1u << 20;
constexpr size_t WS_WGU1 = 2 * MiB, WS_WD1 = 13 * MiB, WS_WIN = 19 * MiB, WS_WC = 27 * MiB, WS_WBA = 28 * MiB, WS_WOUT = 29 * MiB, WS_WGU2 = 31 * MiB, WS_WD2 = 42 * MiB;
constexpr size_t WS_XN = 48 * MiB, WS_HID = 81 * MiB, WS_D = 172 * MiB, WS_H = 238 * MiB, WS_UPOOL = 304 * MiB, WS_Q = 321 * MiB, WS_K = 338 * MiB, WS_VT = 355 * MiB;
constexpr size_t WS_GATES = 371 * MiB, WS_MIXED = 437 * MiB, WS_ATTN = 454 * MiB, WS_SPART = 471 * MiB, WS_DP = 480 * MiB, WS_END = 502 * MiB;
constexpr int SPART_FLOATS = 64 * 64 + 128;
constexpr int LDS_BYTES = 155712;
constexpr int NPH = 14;
#ifndef POOL_REP
#define POOL_REP 1
#endif
#ifndef SAMP_REP
#define SAMP_REP 1
#endif
#ifndef SYNC_REP
#define SYNC_REP 0
#endif
#ifndef ATT_REP
#define ATT_REP 1
#endif
#ifndef REP_MASK
#define REP_MASK 0
#endif

__device__ __forceinline__ float wave_sum(float v) {
#pragma unroll
    for (int o = 1; o < 64; o <<= 1) v += __shfl_xor(v, o);
    return v;
}
__device__ __forceinline__ unsigned pk2(float lo, float hi) { return pg8::cvt_pk_bf16(lo, hi); }
__device__ __forceinline__ bf16x8 pack_bf8(float a0, float a1, float a2, float a3, float a4, float a5, float a6, float a7) {
    u32x4 w; w.x = pk2(a0, a1); w.y = pk2(a2, a3); w.z = pk2(a4, a5); w.w = pk2(a6, a7); return __builtin_bit_cast(bf16x8, w);
}
typedef float f32x2_t __attribute__((ext_vector_type(2))); typedef __bf16 bf16x2_t __attribute__((ext_vector_type(2)));
__device__ __forceinline__ unsigned pk2v(float lo, float hi) { f32x2_t v = {lo, hi}; bf16x2_t b = __builtin_convertvector(v, bf16x2_t); return __builtin_bit_cast(unsigned, b); }
__device__ __forceinline__ bf16x8 pack_bf8v(float a0, float a1, float a2, float a3, float a4, float a5, float a6, float a7) {
    u32x4 w; w.x = pk2v(a0, a1); w.y = pk2v(a2, a3); w.z = pk2v(a4, a5); w.w = pk2v(a6, a7); return __builtin_bit_cast(bf16x8, w);
}
__device__ __forceinline__ f32x16 mfma32(bf16x8 a, bf16x8 b, f32x16 c) { return __builtin_amdgcn_mfma_f32_32x32x16_bf16(a, b, c, 0, 0, 0); }

__device__ __forceinline__ void transpose_item(const float* W, int ldw, int K, bf16* WT, int dst_row0, int src_n0, int k0, LAS float* scr, int lane) {
#pragma unroll 4
    for (int i = 0; i < 16; ++i) { const int kk = 4 * i + (lane >> 4), nn = 4 * (lane & 15); const f32x4 v = *(const f32x4*)(W + (size_t)(k0 + kk) * ldw + src_n0 + nn);
        LAS float* d = scr + kk * 65 + nn; d[0] = v[0]; d[1] = v[1]; d[2] = v[2]; d[3] = v[3]; }
    asm volatile("s_waitcnt lgkmcnt(0)" ::: "memory");
#pragma unroll
    for (int j = 0; j < 8; ++j) { const int q = lane + 64 * j, n = q >> 3, c = q & 7; const LAS float* t = scr + (8 * c) * 65 + n;
        u32x4 o; o.x = pk2(t[0 * 65], t[1 * 65]); o.y = pk2(t[2 * 65], t[3 * 65]); o.z = pk2(t[4 * 65], t[5 * 65]); o.w = pk2(t[6 * 65], t[7 * 65]);
        *(u32x4*)(WT + (size_t)(dst_row0 + n) * K + k0 + 8 * c) = o; }
    asm volatile("s_waitcnt lgkmcnt(0)" ::: "memory");
}
__device__ __forceinline__ void transpose_mat(const float* W, int K, int N, bf16* WT, bool gu, int gw, int NGW, LAS float* scr, int lane) {
    const int nblk = N / 64, nitems = (K / 64) * nblk;
    for (int it = gw; it < nitems; it += NGW) { const int kb = it / nblk, nb = it % nblk; const int src = 64 * nb; int dst = src;
        if (gu) { const int up = src >= DFF ? 1 : 0, sl = src - up * DFF; dst = (sl / 128) * 256 + up * 128 + (sl % 128); }
        transpose_item(W, N, K, WT, dst, src, 64 * kb, scr, lane); }
}
__device__ __forceinline__ const float* xrow_ptr(const float* xp, const float* xs, int row) { return row < MP ? xp + (size_t)row * DMODEL : xs + (size_t)(row - MP) * DMODEL; }
__device__ __forceinline__ void norm_row_bf16(const f32x4 (&v)[4], const float* g, bf16* orow, int lane) {
    float s = 0.f;
#pragma unroll
    for (int j = 0; j < 4; ++j) s += (v[j][0] * v[j][0] + v[j][1] * v[j][1]) + (v[j][2] * v[j][2] + v[j][3] * v[j][3]);
    const float r = 1.0f / sqrtf(wave_sum(s) * (1.f / DMODEL) + EPS);
#pragma unroll
    for (int j = 0; j < 4; ++j) { const f32x4 gg = *((const f32x4*)g + lane + 64 * j); u32x2 w; w.x = pk2(v[j][0] * r * gg[0], v[j][1] * r * gg[1]); w.y = pk2(v[j][2] * r * gg[2], v[j][3] * r * gg[3]);
        *((u32x2*)orow + lane + 64 * j) = w; }
}
__device__ __forceinline__ void resnorm_rows(const float* xp, const float* xs, const float* Hbase, const float* D, const float* DP, int nslab, float rs, const float* gpost, float* outf, const float* gnext, bf16* XN, int gw, int NGW, int lane) {
    for (int row = gw; row < M; row += NGW) {
        const float* b = Hbase ? Hbase + (size_t)row * DMODEL : xrow_ptr(xp, xs, row);
        f32x4 d[4], h[4]; float s = 0.f;
#pragma unroll
        for (int j = 0; j < 4; ++j) { h[j] = *((const f32x4*)b + lane + 64 * j);
            if (row < MP) d[j] = *((const f32x4*)(D + (size_t)row * DMODEL) + lane + 64 * j);
            else { d[j] = *((const f32x4*)(DP + (size_t)(row - MP) * DMODEL) + lane + 64 * j); for (int sl = 1; sl < nslab; ++sl) d[j] += *((const f32x4*)(DP + ((size_t)sl * 512 + row - MP) * DMODEL) + lane + 64 * j); }
            s += (d[j][0] * d[j][0] + d[j][1] * d[j][1]) + (d[j][2] * d[j][2] + d[j][3] * d[j][3]); }
        const float r = rs / sqrtf(wave_sum(s) * (1.f / DMODEL) + EPS);
#pragma unroll
        for (int j = 0; j < 4; ++j) { const f32x4 gg = *((const f32x4*)gpost + lane + 64 * j); h[j] = h[j] + d[j] * gg * r; *((f32x4*)(outf + (size_t)row * DMODEL) + lane + 64 * j) = h[j]; }
        if (gnext) norm_row_bf16(h, gnext, XN + (size_t)row * DMODEL, lane);
    }
}
__device__ __forceinline__ float compute_lam(const float* q1, const float* k1, const float* q2, const float* k2, int lane) {
    const float a = wave_sum(q1[lane] * k1[lane]), b = wave_sum(q2[lane] * k2[lane]);
    const float l = expf(a) - expf(b) + LAM_INIT;
    return __builtin_bit_cast(float, __builtin_amdgcn_readfirstlane(__builtin_bit_cast(int, l)));
}

namespace att {
constexpr int KSTR = 272, VSTR = 144, KBUF = 64 * KSTR, VBUF = 128 * VSTR, STAGE = KBUF + VBUF;
constexpr float C2 = 0.125f * 1.4426950408889634f, THR = 8.0f;
__device__ __forceinline__ int crow(int r, int hi) { return (r & 3) + 8 * (r >> 2) + 4 * hi; }
__device__ __forceinline__ float max3f(float a, float b, float c) { return __builtin_fmaxf(__builtin_fmaxf(a, b), c); }
__device__ __forceinline__ float max16(const f32x16& p) { float m = max3f(p[0], p[1], p[2]); m = max3f(m, p[3], p[4]); m = max3f(m, p[5], p[6]); m = max3f(m, p[7], p[8]);
    m = max3f(m, p[9], p[10]); m = max3f(m, p[11], p[12]); m = max3f(m, p[13], p[14]); return __builtin_fmaxf(m, p[15]); }

__device__ __forceinline__ void finish_store(f32x16 (&o)[4], const float* sg, bf16* orow, int hi) {
    float ss = 0.f;
#pragma unroll
    for (int cb = 0; cb < 4; ++cb)
#pragma unroll
        for (int r = 0; r < 16; ++r) ss += o[cb][r] * o[cb][r];
    ss += __shfl_xor(ss, 32);
    const float rn = (1.0f - LAM_INIT) / sqrtf(ss * (1.f / 128.f) + EPS);
#pragma unroll
    for (int cb = 0; cb < 4; ++cb)
#pragma unroll
        for (int r4 = 0; r4 < 4; ++r4) { const int col = cb * 32 + 8 * r4 + 4 * hi; const f32x4 g = *(const f32x4*)(sg + col);
            u32x2 w; w.x = pk2(o[cb][4 * r4] * rn * g[0], o[cb][4 * r4 + 1] * rn * g[1]); w.y = pk2(o[cb][4 * r4 + 2] * rn * g[2], o[cb][4 * r4 + 3] * rn * g[3]);
            *(u32x2*)(orow + col) = w; }
}

constexpr int DSTG = 32768;
__device__ __forceinline__ void prompt_unit(int h, int qb, const bf16* Q, const bf16* K, const bf16* VT, bf16* ATTN, float lam, const float* sg, LAS char* lds) {
    int tid = threadIdx.x; asm volatile("" : "+v"(tid));
    const int lane = tid & 63, r32 = lane & 31, hi = lane >> 5, wid = __builtin_amdgcn_readfirstlane(tid >> 6), rg = wid & 3, c = wid >> 2;
    const int qrow = 128 * qb + 32 * rg + r32;
    bf16x8 qf0;
    LAS char* qlds = lds + 4 * DSTG + wid * 3072 + lane * 16;
    qf0 = *(const bf16x8*)(Q + (size_t)qrow * 512 + h * 128 + c * 64 + 8 * hi);
#pragma unroll
    for (int d0 = 1; d0 < 4; ++d0) *(LAS bf16x8*)(qlds + (d0 - 1) * 1024) = *(const bf16x8*)(Q + (size_t)qrow * 512 + h * 128 + c * 64 + 16 * d0 + 8 * hi);
#define QFR(d0) ((d0) == 0 ? qf0 : *(const LAS bf16x8*)(qlds + ((d0) - 1) * 1024))
    const int ntiles = 2 * qb + 2, myn = 2 * qb + 1 + (rg >> 1);
    unsigned ksrc0, vsrc0;
    { const int row = 4 * rg + (lane >> 4), ch = (lane & 15) ^ (row & 15); ksrc0 = (unsigned)(row * 512 + h * 128) * 2u + (unsigned)ch * 16u; }
    { const int row = 8 * rg + (lane >> 3), ch = (lane & 7) ^ ((row >> 1) & 7); vsrc0 = (unsigned)((h * 128 + row) * MP) * 2u + (unsigned)ch * 16u; }
    const char* Kc = (const char*)K; const char* Vc = (const char*)VT;
#define ATT_DMA(jt, stg) do { const int jj_ = (jt) < ntiles ? (jt) : ntiles - 1; const char* kt_ = Kc + (size_t)jj_ * (64 * 512 * 2); const char* vt_ = Vc + (size_t)jj_ * 128; \
        _Pragma("unroll") for (int i_ = 0; i_ < 4; ++i_) { \
            __builtin_amdgcn_global_load_lds((const unsigned*)(kt_ + (size_t)i_ * (16 * 512 * 2) + ksrc0), (LAS unsigned*)(lds + (stg) + (rg + 4 * i_) * 1024), 16, 0, 0); \
            __builtin_amdgcn_global_load_lds((const unsigned*)(vt_ + (size_t)i_ * (32 * (size_t)MP * 2) + vsrc0), (LAS unsigned*)(lds + (stg) + 16384 + (rg + 4 * i_) * 1024), 16, 0, 0); } } while (0)
#define WAITV0() asm volatile("s_waitcnt vmcnt(0)" ::: "memory")
#define BAR() do { asm volatile("s_waitcnt lgkmcnt(0)" ::: "memory"); __builtin_amdgcn_s_barrier(); asm volatile("" ::: "memory"); } while (0)
    const int Ak = r32 * 256 + ((c * 8 + hi) ^ (r32 & 15)) * 16, Bv = 16384 + r32 * 128 + (hi ^ ((r32 >> 1) & 7)) * 16;
#define KLD(stg, half, d0) (*(const LAS bf16x8*)(lds + (stg) + (half) * 8192 + (ak_ ^ ((d0) << 5))))
#define VLD(stg, cb, ks) (*(const LAS bf16x8*)(lds + (stg) + (cb) * 4096 + (bv_ ^ ((ks) << 5))))
#define ATT_QK(P0, P1, stg) do { int ak_ = Ak; asm volatile("" : "+v"(ak_)); P0 = f32x16{}; P1 = f32x16{}; \
        _Pragma("unroll") for (int d0 = 0; d0 < 4; ++d0) { const bf16x8 ka = KLD(stg, 0, d0), kc = KLD(stg, 1, d0); P0 = mfma32(ka, QFR(d0), P0); P1 = mfma32(kc, QFR(d0), P1); } } while (0)
#define EX2(P, r) do { P[r] = __builtin_amdgcn_exp2f(P[r] - mref); ls += P[r]; } while (0)
#define SBX() __builtin_amdgcn_sched_barrier(0)
#define S_BLOCK(k, P0, P1) do { \
        float mx = fmaxf(max16(P0), max16(P1)); \
        { const unsigned mu_ = __float_as_uint(mx); auto rr_ = __builtin_amdgcn_permlane32_swap(mu_, mu_, false, false); mx = fmaxf(__uint_as_float(rr_[0]), __uint_as_float(rr_[1])); } \
        if (__any(mx > mref + THR)) { const float nr = fmaxf(mref, mx), al = __builtin_amdgcn_exp2f(mref - nr); mref = nr; lsum *= al; \
            _Pragma("unroll") for (int cb = 0; cb < 4; ++cb) _Pragma("unroll") for (int r = 0; r < 16; ++r) o[cb][r] *= al; } \
        float ls = 0.f; \
        _Pragma("unroll") for (int r = 0; r < 16; ++r) EX2(P0, r); \
        pf0 = pack_bf8v(P0[0], P0[1], P0[2], P0[3], P0[4], P0[5], P0[6], P0[7]); pf1 = pack_bf8v(P0[8], P0[9], P0[10], P0[11], P0[12], P0[13], P0[14], P0[15]); \
        _Pragma("unroll") for (int r = 0; r < 16; ++r) EX2(P1, r); \
        pf2 = pack_bf8v(P1[0], P1[1], P1[2], P1[3], P1[4], P1[5], P1[6], P1[7]); pf3 = pack_bf8v(P1[8], P1[9], P1[10], P1[11], P1[12], P1[13], P1[14], P1[15]); \
        lsum += ls; \
        } while (0)
#define M_BLOCK(k, P0, P1) do { const int sv_ = ((k) & 3) * DSTG, sk_ = (((k) + 2) & 3) * DSTG; bf16x8 va[4], vb[4]; int ak_ = Ak, bv_ = Bv; asm volatile("" : "+v"(ak_), "+v"(bv_));     \
        _Pragma("unroll") for (int cb = 0; cb < 4; ++cb) { va[cb] = VLD(sv_, cb, 0); vb[cb] = VLD(sv_, cb, 1); } \
        SBX(); \
        _Pragma("unroll") for (int cb = 0; cb < 4; ++cb) { o[cb] = mfma32(va[cb], pf0, o[cb]); va[cb] = VLD(sv_, cb, 2); } \
        SBX(); \
        _Pragma("unroll") for (int cb = 0; cb < 4; ++cb) { o[cb] = mfma32(vb[cb], pf1, o[cb]); vb[cb] = VLD(sv_, cb, 3); } \
        SBX(); \
        _Pragma("unroll") for (int cb = 0; cb < 4; ++cb) { o[cb] = mfma32(va[cb], pf2, o[cb]); va[cb] = KLD(sk_, cb & 1, cb >> 1); } \
        SBX(); \
        _Pragma("unroll") for (int cb = 0; cb < 4; ++cb) { o[cb] = mfma32(vb[cb], pf3, o[cb]); vb[cb] = KLD(sk_, cb & 1, 2 + (cb >> 1)); } \
        SBX(); \
        P0 = f32x16{}; P1 = f32x16{}; \
        { const bf16x8 q1_ = QFR(1), q2_ = QFR(2), q3_ = QFR(3); \
        P0 = mfma32(va[0], qf0, P0); P1 = mfma32(va[1], qf0, P1); P0 = mfma32(va[2], q1_, P0); P1 = mfma32(va[3], q1_, P1); \
        P0 = mfma32(vb[0], q2_, P0); P1 = mfma32(vb[1], q2_, P1); P0 = mfma32(vb[2], q3_, P0); P1 = mfma32(vb[3], q3_, P1); } \
        SBX(); } while (0)
    f32x16 o[4];
#pragma unroll
    for (int cb = 0; cb < 4; ++cb) o[cb] = f32x16{};
    float mref = -INFINITY, lsum = 0.f;
    f32x16 e0, e1, d0s, d1s;
    bf16x8 pf0, pf1, pf2, pf3;
    if (c == 0) { ATT_DMA(0, 0); ATT_DMA(1, DSTG); ATT_DMA(2, 2 * DSTG); }
    if (c == 1) __builtin_amdgcn_s_setprio(1);
    WAITV0(); BAR();
    ATT_QK(e0, e1, 0); ATT_QK(d0s, d1s, DSTG);
    if (c == 0) {
        for (int k = 0; k < ntiles; k += 2) {
            if (k < myn) S_BLOCK(k, e0, e1);
            WAITV0(); BAR();
            ATT_DMA(k + 3, ((k + 3) & 3) * DSTG);
            if (k < myn) M_BLOCK(k, e0, e1);
            BAR();
            if (k + 1 < myn) S_BLOCK(k + 1, d0s, d1s);
            WAITV0(); BAR();
            ATT_DMA(k + 4, ((k + 4) & 3) * DSTG);
            if (k + 1 < myn) M_BLOCK(k + 1, d0s, d1s);
            BAR();
        }
        WAITV0(); BAR();
    } else {
        BAR();
        for (int k = 0; k < ntiles; k += 2) {
            if (k < myn) S_BLOCK(k, e0, e1);
            BAR();
            if (k < myn) M_BLOCK(k, e0, e1);
            BAR();
            if (k + 1 < myn) S_BLOCK(k + 1, d0s, d1s);
            BAR();
            if (k + 1 < myn) M_BLOCK(k + 1, d0s, d1s);
            BAR();
        }
    }
#undef QFR
#undef ATT_DMA
#undef WAITV0
#undef BAR
#undef KLD
#undef VLD
#undef ATT_QK
#undef EX2
#undef S_BLOCK
#undef SBX
#undef M_BLOCK
    __builtin_amdgcn_s_setprio(0);
    lsum += __shfl_xor(lsum, 32);
    const float inv = 1.0f / lsum;
    int t2 = threadIdx.x; asm volatile("" : "+v"(t2));
    float lamv = __builtin_bit_cast(float, __builtin_amdgcn_readfirstlane(__builtin_bit_cast(int, lam))); asm volatile("" : "+s"(lamv));
    const int lane2 = t2 & 63, hi2 = lane2 >> 5, qrow2 = 128 * qb + 32 * rg + (lane2 & 31);
    LAS float* xb = (LAS float*)lds + (size_t)rg * 4096 + lane2;
    __syncthreads();
    if (c == 1) {
#pragma unroll
        for (int cb = 0; cb < 4; ++cb)
#pragma unroll
            for (int r = 0; r < 16; ++r) xb[(cb * 16 + r) * 64] = o[cb][r] * inv;
    }
    __syncthreads();
    if (c == 0) {
#pragma unroll
        for (int cb = 0; cb < 4; ++cb)
#pragma unroll
            for (int r = 0; r < 16; ++r) o[cb][r] = o[cb][r] * inv - lamv * xb[(cb * 16 + r) * 64];
        finish_store(o, sg, ATTN + (size_t)qrow2 * 512 + h * 128, hi2);
    }
    __syncthreads();
}

__device__ __forceinline__ void sample_block(const float* Kp, const float* Vp, const bf16x8 (&qf)[2][4], f32x16 (&o)[2][4], float (&mref)[2], float (&lsum)[2], int r32, int hi) {
    bf16x8 pf[2][2];
#pragma unroll
    for (int c = 0; c < 2; ++c) {
        f32x16 p = f32x16{};
#pragma unroll
        for (int d0 = 0; d0 < 4; ++d0) { const float* kp = Kp + (size_t)r32 * 512 + c * 64 + 16 * d0 + 8 * hi; const f32x4 a = *(const f32x4*)kp, b = *(const f32x4*)(kp + 4);
            p = mfma32(pack_bf8(a[0], a[1], a[2], a[3], b[0], b[1], b[2], b[3]), qf[c][d0], p); }
        float mx = max16(p); mx = fmaxf(mx, __shfl_xor(mx, 32));
        const float ms = mx;
        if (__any(ms > mref[c] + THR)) { const float nr = fmaxf(mref[c], ms), al = __builtin_amdgcn_exp2f(mref[c] - nr); mref[c] = nr; lsum[c] *= al;
#pragma unroll
            for (int cb = 0; cb < 4; ++cb)
#pragma unroll
                for (int r = 0; r < 16; ++r) o[c][cb][r] *= al; }
        float ls = 0.f;
#pragma unroll
        for (int r = 0; r < 16; ++r) { p[r] = __builtin_amdgcn_exp2f(p[r] - mref[c]); ls += p[r]; }
        lsum[c] += ls;
        pf[c][0] = pack_bf8(p[0], p[1], p[2], p[3], p[4], p[5], p[6], p[7]); pf[c][1] = pack_bf8(p[8], p[9], p[10], p[11], p[12], p[13], p[14], p[15]);
    }
#pragma unroll
    for (int cb = 0; cb < 4; ++cb)
#pragma unroll
        for (int ks = 0; ks < 2; ++ks) { const float* vp = Vp + (size_t)(16 * ks + 4 * hi) * 512 + cb * 32 + r32;
            const bf16x8 vf = pack_bf8(vp[0], vp[512], vp[1024], vp[1536], vp[8 * 512], vp[9 * 512], vp[10 * 512], vp[11 * 512]);
            o[0][cb] = mfma32(vf, pf[0][ks], o[0][cb]); o[1][cb] = mfma32(vf, pf[1][ks], o[1][cb]); }
}
__device__ __forceinline__ void sample_item(int b, int h, int sp, const bf16* Q, const float* ck, const float* cv, const float* nk, const float* nv, float* SP, LAS char* lds) {
    const int tid = threadIdx.x, lane = tid & 63, r32 = lane & 31, hi = lane >> 5, wid = __builtin_amdgcn_readfirstlane(tid >> 6);
    bf16x8 qf[2][4];
#pragma unroll
    for (int c = 0; c < 2; ++c)
#pragma unroll
        for (int d0 = 0; d0 < 4; ++d0) qf[c][d0] = *(const bf16x8*)(Q + (size_t)(MP + b * 32 + r32) * 512 + h * 128 + c * 64 + 16 * d0 + 8 * hi);
    f32x16 o[2][4];
#pragma unroll
    for (int c = 0; c < 2; ++c)
#pragma unroll
        for (int cb = 0; cb < 4; ++cb) o[c][cb] = f32x16{};
    float mref[2] = {-INFINITY, -INFINITY}, lsum[2] = {0.f, 0.f};
    const size_t key0 = (size_t)b * PASTL + sp * 1024 + wid * 128;
    for (int blk = 0; blk < 4; ++blk) sample_block(ck + (key0 + blk * 32) * 512 + h * 128, cv + (key0 + blk * 32) * 512 + h * 128, qf, o, mref, lsum, r32, hi);
    if (sp == 3 && wid == 7) sample_block(nk + (size_t)b * 32 * 512 + h * 128, nv + (size_t)b * 32 * 512 + h * 128, qf, o, mref, lsum, r32, hi);
    LAS float* mb = (LAS float*)(lds + 131072);
    LAS float* lb = mb + 1024;
    mb[(wid * 2 + 0) * 64 + lane] = mref[0]; mb[(wid * 2 + 1) * 64 + lane] = mref[1];
    __syncthreads();
    float Mx[2];
#pragma unroll
    for (int c = 0; c < 2; ++c) { float m = mb[c * 64 + lane];
#pragma unroll
        for (int w = 1; w < 8; ++w) m = fmaxf(m, mb[(w * 2 + c) * 64 + lane]);
        Mx[c] = m; const float sc = __builtin_amdgcn_exp2f(mref[c] - m); lsum[c] *= sc;
#pragma unroll
        for (int cb = 0; cb < 4; ++cb)
#pragma unroll
            for (int r = 0; r < 16; ++r) o[c][cb][r] *= sc;
        lb[(wid * 2 + c) * 64 + lane] = lsum[c]; }
#pragma unroll
    for (int st = 4; st >= 1; st >>= 1) {
        if (wid >= st && wid < 2 * st) { LAS float* sl = (LAS float*)lds + (size_t)(wid - st) * 8192 + lane;
#pragma unroll
            for (int c = 0; c < 2; ++c)
#pragma unroll
                for (int cb = 0; cb < 4; ++cb)
#pragma unroll
                    for (int r = 0; r < 16; ++r) sl[((c * 4 + cb) * 16 + r) * 64] = o[c][cb][r]; }
        __syncthreads();
        if (wid < st) { const LAS float* sl = (const LAS float*)lds + (size_t)wid * 8192 + lane;
#pragma unroll
            for (int c = 0; c < 2; ++c)
#pragma unroll
                for (int cb = 0; cb < 4; ++cb)
#pragma unroll
                    for (int r = 0; r < 16; ++r) o[c][cb][r] += sl[((c * 4 + cb) * 16 + r) * 64]; }
        __syncthreads();
    }
    if (wid == 0) {
#pragma unroll
        for (int c = 0; c < 2; ++c) { float l = 0.f;
#pragma unroll
            for (int w = 0; w < 8; ++w) l += lb[(w * 2 + c) * 64 + lane];
            l += __shfl_xor(l, 32);
            float* dst = SP + (size_t)(((b * 4 + h) * 4 + sp) * 2 + c) * SPART_FLOATS + lane;
#pragma unroll
            for (int cb = 0; cb < 4; ++cb)
#pragma unroll
                for (int r = 0; r < 16; ++r) dst[(cb * 16 + r) * 64] = o[c][cb][r];
            dst[4096] = Mx[c]; dst[4096 + 64] = l; }
    }
    __syncthreads();
}
__device__ __forceinline__ void sample_combine(int bh, const float* SP, float lam, const float* sg, bf16* ATTN, int lane) {
    const int r32 = lane & 31, hi = lane >> 5;
    float sc[2][4];
#pragma unroll
    for (int c = 0; c < 2; ++c) {
        const float* src = SP + (size_t)((bh * 4) * 2 + c) * SPART_FLOATS + lane;
        float ms[4], m = -INFINITY, l = 0.f;
#pragma unroll
        for (int s = 0; s < 4; ++s) { ms[s] = src[(size_t)s * 2 * SPART_FLOATS + 4096]; m = fmaxf(m, ms[s]); }
#pragma unroll
        for (int s = 0; s < 4; ++s) { sc[c][s] = __builtin_amdgcn_exp2f(ms[s] - m); l += sc[c][s] * src[(size_t)s * 2 * SPART_FLOATS + 4096 + 64]; }
        const float inv = (c == 0 ? 1.0f : -lam) / l;
#pragma unroll
        for (int s = 0; s < 4; ++s) sc[c][s] *= inv;
    }
    f32x16 o[4];
#pragma unroll
    for (int cb = 0; cb < 4; ++cb) { o[cb] = f32x16{};
#pragma unroll
        for (int c = 0; c < 2; ++c)
#pragma unroll
            for (int s = 0; s < 4; ++s) { const float* src = SP + (size_t)((bh * 4 + s) * 2 + c) * SPART_FLOATS + lane;
#pragma unroll
                for (int r = 0; r < 16; ++r) o[cb][r] += sc[c][s] * src[(cb * 16 + r) * 64]; } }
    const int b = bh >> 2, h = bh & 3;
    finish_store(o, sg, ATTN + (size_t)(MP + b * 32 + r32) * 512 + h * 128, hi);
}
}

struct Row8 { float v[8]; };
__device__ __forceinline__ Row8 pool_row(const bf16* UPOOL, const float* state, bool smp, int r0, int b, int idx, int c0) {
    Row8 r;
    if (smp && idx < 0) { const float* sp = state + (size_t)(b * 15 + 15 + idx) * 512 + c0; const f32x4 x = *(const f32x4*)sp, y = *(const f32x4*)(sp + 4);
        r.v[0] = x[0]; r.v[1] = x[1]; r.v[2] = x[2]; r.v[3] = x[3]; r.v[4] = y[0]; r.v[5] = y[1]; r.v[6] = y[2]; r.v[7] = y[3]; return r; }
    if (!smp && r0 + idx < 0) {
#pragma unroll
        for (int i = 0; i < 8; ++i) r.v[i] = 0.f;
        return r; }
    const u32x4 w = *(const u32x4*)(UPOOL + (size_t)(r0 + idx) * 512 + c0);
    r.v[0] = pg8::bf_lo(w.x); r.v[1] = pg8::bf_hi(w.x); r.v[2] = pg8::bf_lo(w.y); r.v[3] = pg8::bf_hi(w.y); r.v[4] = pg8::bf_lo(w.z); r.v[5] = pg8::bf_hi(w.z); r.v[6] = pg8::bf_lo(w.w); r.v[7] = pg8::bf_hi(w.w);
    return r;
}
__device__ __forceinline__ void pool_phase(const bf16* UPOOL, const float* state, bf16* MIXED, int gtid, int nthr) {
    for (int it = gtid; it < (M / 32) * 64; it += nthr) {
        const int strip = it >> 6, cg8 = it & 63, c0 = cg8 * 8, w = 2 << (cg8 >> 4), r0 = strip * 32;
        const bool smp = r0 >= MP; const int b = smp ? (r0 - MP) >> 5 : 0;
        float s[8] = {0.f, 0.f, 0.f, 0.f, 0.f, 0.f, 0.f, 0.f};
        for (int idx = 1 - w; idx < 0; ++idx) { const Row8 r = pool_row(UPOOL, state, smp, r0, b, idx, c0);
#pragma unroll
            for (int i = 0; i < 8; ++i) s[i] += r.v[i]; }
        for (int t = 0; t < 32; ++t) {
            const Row8 cur = pool_row(UPOOL, state, smp, r0, b, t, c0), old = pool_row(UPOOL, state, smp, r0, b, t - w + 1, c0);
            const int have = smp ? w : (r0 + t + 1 < w ? r0 + t + 1 : w); const float ic = 1.0f / (float)have;
            float o[8];
#pragma unroll
            for (int i = 0; i < 8; ++i) { s[i] += cur.v[i]; o[i] = s[i] * ic - cur.v[i]; s[i] -= old.v[i]; }
            u32x4 ov; ov.x = pk2(o[0], o[1]); ov.y = pk2(o[2], o[3]); ov.z = pk2(o[4], o[5]); ov.w = pk2(o[6], o[7]);
            *(u32x4*)(MIXED + (size_t)(r0 + t) * 512 + c0) = ov;
        }
    }
}

#define XB_TMO      128
#define XB_XCNT(j)  (256  + 64 * (j))
#define XB_XSUB(j)  (1280 + 64 * (j))
#define XB_XGEN(j)  (2304 + 64 * (j))
#define XB_TOP      3328
#define XB_TOPGEN   3392
#define XCD_BAR_WORDS 3456
#define XB_SPIN_CAP (1u << 18)

__device__ __forceinline__ unsigned xb_ld(unsigned* p)              { return __hip_atomic_load(p, __ATOMIC_RELAXED, __HIP_MEMORY_SCOPE_AGENT); }
__device__ __forceinline__ unsigned xb_add(unsigned* p, unsigned v) { return __hip_atomic_fetch_add(p, v, __ATOMIC_RELAXED, __HIP_MEMORY_SCOPE_AGENT); }
__device__ __forceinline__ unsigned xb_xcc_id() { return (unsigned)__builtin_amdgcn_s_getreg((3 << 11) | 20) & 0xFu; }
#define XB_SPIN(cond, bar) do { unsigned _sp = 0; while (cond) { __builtin_amdgcn_s_sleep(1); \
    if ((++_sp & 255u) == 0u) { if (xb_ld(&(bar)[XB_TMO])) break; if (_sp > XB_SPIN_CAP) { atomicAdd(&(bar)[XB_TMO], 1u); break; } } } } while (0)

struct XcdBarrier {
    unsigned* bar; unsigned x;
    volatile LAS unsigned* st;
};

__device__ __forceinline__ XcdBarrier xcd_barrier_post(unsigned* bar, volatile LAS unsigned* st) {
    XcdBarrier b; b.bar = bar; b.x = xb_xcc_id(); b.st = st;
    if (threadIdx.x == 0) (void)xb_add(&bar[XB_XCNT(b.x)], 1u);
    return b;
}
__device__ __forceinline__ void xcd_barrier_complete(unsigned* bar, unsigned x, unsigned& nloc, unsigned& nx) {
    const unsigned G = gridDim.x * gridDim.y * gridDim.z;
    unsigned sum, cnt, mine, sp = 0u;
    for (;;) {
        sum = 0u; cnt = 0u; mine = 0u;
#pragma unroll
        for (unsigned j = 0; j < 16; ++j) { const unsigned c = xb_ld(&bar[XB_XCNT(j)]); sum += c; cnt += (c > 0u) ? 1u : 0u; mine = (j == x) ? c : mine; }
        if (sum == G) break;
        __builtin_amdgcn_s_sleep(1);
        if ((++sp & 255u) == 0u) { if (xb_ld(&bar[XB_TMO])) break; if (sp > XB_SPIN_CAP) { atomicAdd(&bar[XB_TMO], 1u); break; } }
    }
    nloc = mine > 0u ? mine : 1u; nx = cnt > 0u ? cnt : 1u;
}

__device__ __forceinline__ void xcd_barrier(const XcdBarrier& b) {
    asm volatile("s_waitcnt vmcnt(0)" ::: "memory");
    __syncthreads();
    if (threadIdx.x == 0) {
        unsigned* bar = b.bar;
        __builtin_amdgcn_s_waitcnt(0);
        unsigned nloc = b.st[0], nx = b.st[1];
        if (nloc == 0u) { xcd_barrier_complete(bar, b.x, nloc, nx); b.st[0] = nloc; b.st[1] = nx; }
        const unsigned old = xb_add(&bar[XB_XSUB(b.x)], 1u);
        const unsigned gen = old / nloc;
        if (old + 1u == (gen + 1u) * nloc) {
            __builtin_amdgcn_fence(__ATOMIC_RELEASE, "agent");
            asm volatile("s_waitcnt vmcnt(0)" ::: "memory");
            const unsigned og = xb_add(&bar[XB_TOP], 1u);
            const unsigned tg = og / nx;
            if (og + 1u == (tg + 1u) * nx) xb_add(&bar[XB_TOPGEN], 1u);
            else XB_SPIN(xb_ld(&bar[XB_TOPGEN]) == tg, bar);
            __builtin_amdgcn_fence(__ATOMIC_ACQUIRE, "agent");
            xb_add(&bar[XB_XGEN(b.x)], 1u);
            asm volatile("s_waitcnt vmcnt(0)" ::: "memory");
        } else {
            XB_SPIN(xb_ld(&bar[XB_XGEN(b.x)]) == gen, bar);
            __builtin_amdgcn_fence(__ATOMIC_ACQUIRE, "agent");
            asm volatile("s_waitcnt vmcnt(0)" ::: "memory");
        }
    }
    __syncthreads();
}

struct Args { const float* in[26]; float* out; unsigned char* ws; double rc[8]; int ph_lo, ph_hi; };
__global__ void __launch_bounds__(512, 2) fwd_mega(Args a) {
    extern __shared__ __attribute__((aligned(16))) unsigned char lds_raw[];
    LAS unsigned char* lds = (LAS unsigned char*)lds_raw;
    cg::grid_group grid = cg::this_grid();
    const int tid = threadIdx.x, lane = tid & 63, wid = __builtin_amdgcn_readfirstlane(tid >> 6);
    const int G = gridDim.x, gw = blockIdx.x * 8 + wid, NGW = G * 8;
    unsigned char* ws = a.ws;
    bf16 *WGU1 = (bf16*)(ws + WS_WGU1), *WD1 = (bf16*)(ws + WS_WD1), *WIN = (bf16*)(ws + WS_WIN), *WC = (bf16*)(ws + WS_WC), *WBA = (bf16*)(ws + WS_WBA), *WOUT = (bf16*)(ws + WS_WOUT), *WGU2 = (bf16*)(ws + WS_WGU2), *WD2 = (bf16*)(ws + WS_WD2);
    bf16 *XN = (bf16*)(ws + WS_XN), *HID = (bf16*)(ws + WS_HID), *UPOOL = (bf16*)(ws + WS_UPOOL), *QB = (bf16*)(ws + WS_Q), *KB = (bf16*)(ws + WS_K), *VT = (bf16*)(ws + WS_VT), *GATES = (bf16*)(ws + WS_GATES), *MIXED = (bf16*)(ws + WS_MIXED), *ATTN = (bf16*)(ws + WS_ATTN);
    float *D = (float*)(ws + WS_D), *H = (float*)(ws + WS_H), *SPART = (float*)(ws + WS_SPART), *DP = (float*)(ws + WS_DP);
    const float *xp = a.in[0], *xs = a.in[1];
    volatile LAS unsigned* MISC = (volatile LAS unsigned*)(lds + LDS_BYTES - 64);
    if (tid < 16) MISC[tid] = 0u;
    __syncthreads();
    unsigned* barw = (unsigned*)ws;
    XcdBarrier bar = xcd_barrier_post(barw, MISC);
    if (a.ph_lo < 0) grid.sync();
    const int lo = a.ph_lo, hi_ = a.ph_hi;
#define IN(k) (lo <= (k) && (k) < hi_)
#define REPEAT(k) for (int rep_ = 0; rep_ < 1 + ((REP_MASK >> (k)) & 1); ++rep_, (rep_ < 1 + ((REP_MASK >> (k)) & 1) ? grid.sync() : (void)0))
#define SEAM(k) do { if (IN(k) && IN((k) + 1)) xcd_barrier(bar); } while (0)

    for (int rz_ = 0; rz_ < SYNC_REP; ++rz_) grid.sync();
    if (IN(0)) REPEAT(0) {
        LAS float* scr = (LAS float*)(lds + wid * 16640);
        transpose_mat(a.in[7], DMODEL, NGU, WGU1, true, gw, NGW, scr, lane);
        transpose_mat(a.in[8], DFF, DMODEL, WD1, false, gw, NGW, scr, lane);
        transpose_mat(a.in[11], DMODEL, 4096, WIN, false, gw, NGW, scr, lane);
        transpose_mat(a.in[20], 512, DMODEL, WBA, false, gw, NGW, scr, lane);
        transpose_mat(a.in[21], DMODEL, DMODEL, WOUT, false, gw, NGW, scr, lane);
        transpose_mat(a.in[24], DMODEL, NGU, WGU2, true, gw, NGW, scr, lane);
        transpose_mat(a.in[25], DFF, DMODEL, WD2, false, gw, NGW, scr, lane);
        { const float *pw = a.in[12], *psc = a.in[13], *wbp = a.in[19];
          for (int it = gw; it < 64 * 16; it += NGW) { const int kg = it >> 4, e = (it & 15) * 64 + lane, g = kg >> 4, cbase = (kg & 15) * 8;
              float acc8[8] = {0.f, 0.f, 0.f, 0.f, 0.f, 0.f, 0.f, 0.f};
              for (int j = 0; j < 128; ++j) { const float wv = wbp[(size_t)(g * 128 + j) * DMODEL + e] * psc[g * 128 + j];
#pragma unroll
                  for (int i = 0; i < 8; ++i) acc8[i] += pw[(size_t)(g * 128 + cbase + i) * 128 + j] * wv; }
              u32x4 o; o.x = pk2(acc8[0], acc8[1]); o.y = pk2(acc8[2], acc8[3]); o.z = pk2(acc8[4], acc8[5]); o.w = pk2(acc8[6], acc8[7]);
              *(u32x4*)(WC + (size_t)e * 512 + g * 128 + cbase) = o; } }
        for (int row = gw; row < M; row += NGW) { const float* xr = xrow_ptr(xp, xs, row); f32x4 v[4];
#pragma unroll
            for (int j = 0; j < 4; ++j) v[j] = *((const f32x4*)xr + lane + 64 * j);
            norm_row_bf16(v, a.in[5], XN + (size_t)row * DMODEL, lane); }
    }
    SEAM(0);
    if (IN(1)) REPEAT(1) { pg8::Gemm g{XN, WGU1, M, NGU, DMODEL}; pg8::StaticOrder S; S.init(M, NGU, G, (int)blockIdx.x, g.K); pg8::EpiSwiglu E{HID, DFF};
        pg8::gemm_phase<pg8::EpiSwiglu, pg8::StaticOrder, true, true>(lds, g, S, E); }
    SEAM(1);
    if (IN(2)) REPEAT(2) { pg8::Gemm g{HID, WD1, M, DMODEL, DFF}; pg8::SplitOrder S; S.init(DMODEL, G, (int)blockIdx.x, g.K, 11); pg8::EpiF32 E{D, DMODEL, DP};
        pg8::gemm_phase<pg8::EpiF32, pg8::SplitOrder, true, true>(lds, g, S, E); }
    SEAM(2);
    if (IN(3)) REPEAT(3) resnorm_rows(xp, xs, nullptr, D, DP, 11, 0.5f, a.in[6], H, a.in[9], XN, gw, NGW, lane);
    SEAM(3);
    if (IN(4)) REPEAT(4) { pg8::Gemm g{XN, WIN, M, 4096, DMODEL}; pg8::StaticOrder S; S.init(M, 4096, G, (int)blockIdx.x, g.K);
        pg8::EpiWin E{UPOOL, QB, KB, VT, GATES, a.out, {a.rc[0], a.rc[1], a.rc[2], a.rc[3], a.rc[4], a.rc[5], a.rc[6], a.rc[7]}};
        pg8::gemm_phase<pg8::EpiWin, pg8::StaticOrder, true, true>(lds, g, S, E); }
    SEAM(4);
    if (IN(5)) REPEAT(5) {
        for (int rq_ = 0; rq_ < POOL_REP; ++rq_) pool_phase(UPOOL, a.in[4], MIXED, blockIdx.x * 512 + tid, G * 512);
        const float lam = compute_lam(a.in[14], a.in[15], a.in[16], a.in[17], lane);
        for (int rs_ = 0; rs_ < SAMP_REP; ++rs_)
        for (int it = blockIdx.x; it < 256; it += G) att::sample_item(it >> 4, (it >> 2) & 3, it & 3, QB, a.in[2], a.in[3], a.out + OFF_KS, a.out + OFF_VS, SPART, (LAS char*)lds);
        for (int rp_ = 0; rp_ < ATT_REP; ++rp_)
        for (int p = blockIdx.x; p < 256; p += G) { const int h = p >> 6, s = p & 63;
            att::prompt_unit(h, 127 - s, QB, KB, VT, ATTN, lam, a.in[18], (LAS char*)lds);
            att::prompt_unit(h, s, QB, KB, VT, ATTN, lam, a.in[18], (LAS char*)lds); }
    }
    SEAM(5);
    if (IN(6)) REPEAT(6) { const float lam = compute_lam(a.in[14], a.in[15], a.in[16], a.in[17], lane);
        for (int bh = gw; bh < 64; bh += NGW) att::sample_combine(bh, SPART, lam, a.in[18], ATTN, lane); }
    SEAM(6);
    if (IN(7)) REPEAT(7) { pg8::Gemm g{MIXED, WC, M, DMODEL, 512}; pg8::StaticOrder S; S.init(M, DMODEL, G, (int)blockIdx.x, g.K); pg8::EpiMergeA E{GATES, D};
        pg8::gemm_phase<pg8::EpiMergeA, pg8::StaticOrder, true, true>(lds, g, S, E); }
    if (IN(8)) REPEAT(8) { pg8::Gemm g{ATTN, WBA, M, DMODEL, 512}; pg8::StaticOrder S; S.init(M, DMODEL, G, (int)blockIdx.x, g.K); pg8::EpiMergeB E{GATES, D, XN};
        pg8::gemm_phase<pg8::EpiMergeB, pg8::StaticOrder, true, true>(lds, g, S, E); }
    SEAM(8);
    if (IN(9)) REPEAT(9) { pg8::Gemm g{XN, WOUT, M, DMODEL, DMODEL}; pg8::SplitOrder S; S.init(DMODEL, G, (int)blockIdx.x, g.K, 4); pg8::EpiF32 E{D, DMODEL, DP};
        pg8::gemm_phase<pg8::EpiF32, pg8::SplitOrder, true, true>(lds, g, S, E); }
    SEAM(9);
    if (IN(10)) REPEAT(10) resnorm_rows(xp, xs, H, D, DP, 4, 1.0f, a.in[10], H, a.in[22], XN, gw, NGW, lane);
    SEAM(10);
    if (IN(11)) REPEAT(11) { pg8::Gemm g{XN, WGU2, M, NGU, DMODEL}; pg8::StaticOrder S; S.init(M, NGU, G, (int)blockIdx.x, g.K); pg8::EpiSwiglu E{HID, DFF};
        pg8::gemm_phase<pg8::EpiSwiglu, pg8::StaticOrder, true, true>(lds, g, S, E); }
    SEAM(11);
    if (IN(12)) REPEAT(12) { pg8::Gemm g{HID, WD2, M, DMODEL, DFF}; pg8::SplitOrder S; S.init(DMODEL, G, (int)blockIdx.x, g.K, 11); pg8::EpiF32 E{D, DMODEL, DP};
        pg8::gemm_phase<pg8::EpiF32, pg8::SplitOrder, true, true>(lds, g, S, E); }
    SEAM(12);
    if (IN(13)) REPEAT(13) resnorm_rows(xp, xs, H, D, DP, 11, 0.5f, a.in[23], a.out, nullptr, nullptr, gw, NGW, lane);
#undef IN
#undef SEAM
}

#ifndef N_LAUNCH_PER_PHASE
#define N_LAUNCH_PER_PHASE 0
#endif
extern "C" void kernel_launch(void* const* d_in, const int* in_sizes, int n_in, void* d_out, int out_size, void* d_ws, size_t ws_size, hipStream_t stream) {
    static int grid = 0;
    if (grid == 0) {
        if (n_in != 26 || (size_t)out_size != OUT_TOTAL || ws_size < WS_END) { fprintf(stderr, "kernel_launch: unexpected sizes n_in %d out %d ws %zu\n", n_in, out_size, ws_size); grid = -1; return; }
        int dev = 0, cus = 0, per_cu = 0;
        hipGetDevice(&dev); hipDeviceGetAttribute(&cus, hipDeviceAttributeMultiprocessorCount, dev);
        hipFuncSetAttribute((const void*)fwd_mega, hipFuncAttributeMaxDynamicSharedMemorySize, LDS_BYTES);
        hipOccupancyMaxActiveBlocksPerMultiprocessor(&per_cu, (const void*)fwd_mega, 512, LDS_BYTES);
        if (per_cu < 1) { fprintf(stderr, "kernel_launch: occupancy query says %d\n", per_cu); per_cu = 1; }
        (void)hipGetLastError();
        grid = cus * (per_cu > 1 ? 1 : per_cu);
    }
    if (grid < 0) return;
    Args a{};
    for (int i = 0; i < 26; ++i) a.in[i] = (const float*)d_in[i];
    a.out = (float*)d_out; a.ws = (unsigned char*)d_ws;
    for (int i = 0; i < 8; ++i) a.rc[i] = pow(500000.0, -(double)i / 8.0) / (2.0 * M_PI);
#if N_LAUNCH_PER_PHASE
    for (int p = 0; p < NPH; ++p) { a.ph_lo = p; a.ph_hi = p + 1; hipLaunchKernelGGL(fwd_mega, dim3(grid), dim3(512), LDS_BYTES, stream, a); }
#else
    a.ph_lo = 0; a.ph_hi = NPH;
    if (hipMemsetAsync(d_ws, 0, XCD_BAR_WORDS * sizeof(unsigned), stream) != hipSuccess) { fprintf(stderr, "kernel_launch: memset of the barrier words failed\n"); return; }
    void* args[] = {&a};
    hipError_t e = hipLaunchCooperativeKernel((const void*)fwd_mega, dim3(grid), dim3(512), args, LDS_BYTES, stream);
    if (e != hipSuccess) fprintf(stderr, "cooperative launch failed: %s (grid %d)\n", hipGetErrorString(e), grid);
#endif
}
```
